# Optimizing an MI355X kernel written in HIP

```python
import jax, jax.numpy as jnp
from jax import lax
import numpy as np

D_MODEL = 1024
BATCH = 8
SEQ = 4096
DEPTH = 1

ATTN_WIDTH = D_MODEL // 2
HGRN_WIDTH = D_MODEL - ATTN_WIDTH
MIX_WIDTH = ATTN_WIDTH + HGRN_WIDTH
ATTN_HEAD_DIM = 64
ATTN_HEADS = ATTN_WIDTH // ATTN_HEAD_DIM
HGRN_EXPAND = 128
HGRN_HEADS = HGRN_WIDTH // HGRN_EXPAND
DILATED_PATTERNS = ((128, 1), (512, 4), (2048, 16))
ATTN_BLOCK = 128
ROPE_THETA = 500000.0
ROPE_DIMS = ATTN_HEAD_DIM // 4
HGRN_CHUNK = 64
NORM_EPS = 1e-6
IN_COLS = 4 * ATTN_WIDTH + 4 * HGRN_WIDTH

kernel_name = "hymba_dilated_attn_hgrn2_hybrid"


def _rmsnorm(x, w):
    xf = x.astype(jnp.float32)
    y = xf * lax.rsqrt(jnp.mean(xf * xf, axis=-1, keepdims=True) + NORM_EPS)
    return (y * w.astype(jnp.float32)).astype(x.dtype)


def _head_rmsnorm(o, w, n_heads):
    b, s, width = o.shape
    oh = o.reshape(b, s, n_heads, width // n_heads)
    oh = oh * lax.rsqrt(jnp.mean(oh * oh, axis=-1, keepdims=True) + NORM_EPS)
    return oh.reshape(b, s, width) * w.astype(jnp.float32)


def _partial_rotary(t, positions):
    half = ROPE_DIMS // 2
    inv_freq = ROPE_THETA ** (-jnp.arange(half, dtype=jnp.float32) * (2.0 / ROPE_DIMS))
    ang = positions.astype(jnp.float32)[..., None] * inv_freq
    cos = jnp.cos(ang)[:, :, None, :]
    sin = jnp.sin(ang)[:, :, None, :]
    t = t.astype(jnp.float32)
    t1, t2, rest = t[..., :half], t[..., half:ROPE_DIMS], t[..., ROPE_DIMS:]
    return jnp.concatenate([t1 * cos - t2 * sin, t2 * cos + t1 * sin, rest], axis=-1)


def _dilated_window_attn(q, k, v, window, dilation):
    b, h, s, e = q.shape
    span = window // dilation
    sub_len = s // dilation
    n_blk = -(-sub_len // ATTN_BLOCK)
    pad = n_blk * ATTN_BLOCK - sub_len

    def to_blocks(t):
        t = t.reshape(b, h, sub_len, dilation, e).transpose(0, 1, 3, 2, 4)
        t = jnp.pad(t, ((0, 0), (0, 0), (0, 0), (0, pad), (0, 0)))
        return t.reshape(b, h, dilation, n_blk, ATTN_BLOCK, e)

    def with_prev(t):
        prev = jnp.concatenate([jnp.zeros_like(t[:, :, :, :1]), t[:, :, :, :-1]], axis=3)
        return jnp.concatenate([prev, t], axis=4)

    qb, kb, vb = to_blocks(q), to_blocks(k), to_blocks(v)
    kw, vw = with_prev(kb), with_prev(vb)
    scores = jnp.einsum('bhrnqe,bhrnke->bhrnqk', qb, kw) * (e ** -0.5)
    qi = jnp.arange(ATTN_BLOCK)[:, None]
    kj = jnp.arange(2 * ATTN_BLOCK)[None, :]
    dist = ATTN_BLOCK + qi - kj
    band = (dist >= 0) & (dist <= span)
    first = (jnp.arange(n_blk) == 0)[:, None, None]
    mask = band[None] & ~(first & (kj < ATTN_BLOCK)[None])
    scores = jnp.where(mask, scores, -jnp.inf)
    m = jnp.max(scores, axis=-1)
    p = jnp.exp(scores - m[..., None])
    l = jnp.sum(p, axis=-1)
    o = jnp.einsum('bhrnqk,bhrnke->bhrnqe', p, vw)

    def from_blocks(t):
        tail = t.shape[5:]
        t = t.reshape(b, h, dilation, n_blk * ATTN_BLOCK, *tail)[:, :, :, :sub_len]
        t = jnp.moveaxis(t, 2, 3)
        return t.reshape(b, h, s, *tail)

    return from_blocks(o), from_blocks(m), from_blocks(l)


def _longnet_mixture(q, k, v):
    outs = [_dilated_window_attn(q, k, v, w, d) for (w, d) in DILATED_PATTERNS]
    m_all = jnp.stack([o[1] for o in outs], axis=0)
    m_top = jnp.max(m_all, axis=0)
    wts = jnp.exp(m_all - m_top)
    num = sum(wts[i][..., None] * outs[i][0] for i in range(len(outs)))
    den = sum(wts[i] * outs[i][2] for i in range(len(outs)))
    return num / den[..., None]


def _hgrn2_chunked(q, k, v, log_f):
    b, h, s, e = q.shape
    ev = v.shape[-1]
    nc = s // HGRN_CHUNK
    rs = lambda t: t.reshape(b, h, nc, HGRN_CHUNK, t.shape[-1])
    q, k, v, log_f = rs(q), rs(k), rs(v), rs(log_f)
    cum = jnp.cumsum(log_f, axis=3)
    last = cum[:, :, :, -1:]
    q_dec = q * jnp.exp(cum)
    k_inv = k * jnp.exp(-cum)
    k_end = k * jnp.exp(last - cum)
    causal = jnp.tril(jnp.ones((HGRN_CHUNK, HGRN_CHUNK), dtype=bool))
    att = jnp.where(causal, jnp.einsum('bhnte,bhnse->bhnts', q_dec, k_inv), 0.0)
    o_intra = jnp.einsum('bhnts,bhnsv->bhntv', att, v)
    chunk_decay = jnp.exp(last[:, :, :, 0])

    def step(state, xs):
        qd, ke, vc, dec = xs
        o = jnp.einsum('bhte,bhev->bhtv', qd, state)
        state = dec[..., None] * state + jnp.einsum('bhte,bhtv->bhev', ke, vc)
        return state, o

    xs = (jnp.moveaxis(q_dec, 2, 0), jnp.moveaxis(k_end, 2, 0),
          jnp.moveaxis(v, 2, 0), jnp.moveaxis(chunk_decay, 2, 0))
    state0 = jnp.zeros((b, h, e, ev), jnp.float32)
    _, o_inter = lax.scan(step, state0, xs)
    o = o_intra + jnp.moveaxis(o_inter, 0, 2)
    return o.reshape(b, h, s, ev)


def setup_inputs(seed: int = 0) -> dict:
    key = jax.random.key(seed)
    ks = jax.random.split(key, 10)
    x = jax.random.normal(ks[0], (BATCH, SEQ, D_MODEL), jnp.float32)
    offset = jax.random.randint(ks[1], (BATCH, 1), 0, 4096, dtype=jnp.int32)
    positions = (offset + jnp.arange(SEQ, dtype=jnp.int32)[None, :]).astype(jnp.int32)
    w_in = jax.random.normal(ks[2], (DEPTH, D_MODEL, IN_COLS), jnp.float32) * D_MODEL ** -0.5
    w_out = jax.random.normal(ks[3], (DEPTH, MIX_WIDTH, D_MODEL), jnp.float32) * MIX_WIDTH ** -0.5
    mix_norm_w = 1.0 + 0.02 * jax.random.normal(ks[4], (DEPTH, D_MODEL), jnp.float32)
    attn_out_norm_w = 1.0 + 0.02 * jax.random.normal(ks[5], (DEPTH, ATTN_WIDTH), jnp.float32)
    hgrn_out_norm_w = 1.0 + 0.02 * jax.random.normal(ks[6], (DEPTH, HGRN_WIDTH), jnp.float32)
    hgrn_lb_raw = 0.1 * jax.random.normal(ks[7], (DEPTH + 1, HGRN_WIDTH), jnp.float32)
    final_norm_w = 1.0 + 0.02 * jax.random.normal(ks[8], (D_MODEL,), jnp.float32)
    return {"x": x, "positions": positions, "w_in": w_in, "w_out": w_out,
            "mix_norm_w": mix_norm_w, "attn_out_norm_w": attn_out_norm_w,
            "hgrn_out_norm_w": hgrn_out_norm_w, "hgrn_lb_raw": hgrn_lb_raw,
            "final_norm_w": final_norm_w}


def reference(x, positions, w_in, w_out, mix_norm_w, attn_out_norm_w,
              hgrn_out_norm_w, hgrn_lb_raw, final_norm_w):
    b, s, _ = x.shape
    f32 = jnp.float32
    lower_bounds = jnp.cumsum(jax.nn.softmax(hgrn_lb_raw.astype(f32), axis=0), axis=0)
    split_at = [ATTN_WIDTH * i for i in range(1, 5)] + \
               [4 * ATTN_WIDTH + HGRN_WIDTH * i for i in range(1, 4)]
    for layer in range(DEPTH):
        hn = _rmsnorm(x, mix_norm_w[layer])
        proj = hn @ w_in[layer]
        aq, ak, av, ag, hq, hf, hi, hg = jnp.split(proj, split_at, axis=-1)

        aq = _partial_rotary(aq.reshape(b, s, ATTN_HEADS, ATTN_HEAD_DIM), positions)
        ak = _partial_rotary(ak.reshape(b, s, ATTN_HEADS, ATTN_HEAD_DIM), positions)
        av = av.reshape(b, s, ATTN_HEADS, ATTN_HEAD_DIM).astype(f32)
        bhse = lambda t: t.transpose(0, 2, 1, 3)
        attn = _longnet_mixture(bhse(aq), bhse(ak), bhse(av))
        attn = attn.transpose(0, 2, 1, 3).reshape(b, s, ATTN_WIDTH)

        lb = lower_bounds[layer]
        f = lb + (1.0 - lb) * jax.nn.sigmoid(hf.astype(f32))
        hkey = 1.0 - f
        hquery = jax.nn.silu(hq.astype(f32))
        hh = lambda t: t.reshape(b, s, HGRN_HEADS, HGRN_EXPAND).transpose(0, 2, 1, 3)
        rec = _hgrn2_chunked(hh(hquery), hh(hkey), hh(hi.astype(f32)), hh(jnp.log(f)))
        rec = rec.transpose(0, 2, 1, 3).reshape(b, s, HGRN_WIDTH)

        y_attn = _head_rmsnorm(attn, attn_out_norm_w[layer], ATTN_HEADS) * jax.nn.silu(ag.astype(f32))
        y_hgrn = _head_rmsnorm(rec, hgrn_out_norm_w[layer], HGRN_HEADS) * jax.nn.silu(hg.astype(f32))
        mixed = jnp.concatenate([y_attn, y_hgrn], axis=-1).astype(x.dtype)
        x = x + mixed @ w_out[layer]
    return _rmsnorm(x, final_norm_w)
```

```cpp
#include <hip/hip_runtime.h>
#include <cstdio>
#include <cstdint>
namespace pg8 {
#define PG8_LAS __attribute__((address_space(3)))
typedef unsigned short bf16_t;
typedef short bf16x8 __attribute__((ext_vector_type(8)));
typedef float f32x4 __attribute__((ext_vector_type(4)));
typedef unsigned u32x4 __attribute__((ext_vector_type(4)));
constexpr int BM = 256, BK = 64, HALF = 128, HTB = HALF * BK * 2  , STAGE_BYTES = 8 * HTB, NXCD = 8, WGM = 8;

__host__ __device__ __forceinline__ int lds_byte(int r, int c) { const int st = (r >> 4) * 2 + (c >> 5), rr = r & 15, cc = c & 31, ob = rr * 64 + cc * 2; return st * 1024 + (ob ^ (((ob >> 9) & 1) << 5)); }
__host__ __device__ __forceinline__ void stage_rc(int b, int& R, int& C) { const int st = b / 1024, sb = b % 1024, swz = sb ^ (((sb >> 9) & 1) << 5); R = (st >> 1) * 16 + swz / 64; C = (st & 1) * 32 + (swz % 64) / 2; }
__host__ __device__ __forceinline__ int perm32(int rho) { const int n = rho >> 4, i = rho & 15; return 8 * (i >> 2) + 4 * n + (i & 3); }

struct Unit { int pm, pn; };
struct Gemm { const bf16_t* A; const bf16_t* Bt; int M, N, K; };

struct StaticOrder {
    int nM, nN, nwg, G, c;
    __host__ __device__ void init(int M, int N, int G_, int c_) { nM = M / BM; nN = N / BM; nwg = nM * nN; G = G_; c = c_; }
    __host__ __device__ bool next(int i, Unit& u) const {
        const long L = (long)i * G + c; if (L >= nwg) return false;
        int wgid = (int)L; { const int q = nwg / NXCD, r = nwg % NXCD, xcd = wgid % NXCD, off = wgid / NXCD; wgid = (xcd < r ? xcd * (q + 1) : r * (q + 1) + (xcd - r) * q) + off; }
        const int nig = WGM * nN, gid = wgid / nig, fm = gid * WGM, gsz = (nM - fm) < WGM ? (nM - fm) : WGM;
        u.pm = fm + ((wgid % nig) % gsz); u.pn = (wgid % nig) / gsz; return true;
    }
    __device__ __forceinline__ void a_ready(const Unit&) const {}
    __device__ __forceinline__ void done(const Unit&) const {}
};

__device__ __forceinline__ unsigned cvt_pk_bf16(float lo, float hi) { unsigned r; asm volatile("v_cvt_pk_bf16_f32 %0, %1, %2" : "=v"(r) : "v"(lo), "v"(hi)); return r; }
typedef float f32x2 __attribute__((ext_vector_type(2)));
template <class Epi, class Sched, bool ALIGN_EPI = false, bool SP2 = false>
__device__ __forceinline__ void gemm_phase(PG8_LAS unsigned char* lds, const Gemm g, const Sched& S, const Epi& E) {
    const int tid = threadIdx.x, wid = __builtin_amdgcn_readfirstlane(tid >> 6), lane = tid & 63, wr = wid >> 2, wc = wid & 3, fr = lane & 15, fq = lane >> 4;
    const int K = g.K, nt = K / BK;
    unsigned voffA[2], voffB[2];
#pragma unroll
    for (int i = 0; i < 2; ++i) { int R, C; stage_rc(tid * 16 + i * 8192, R, C); const int Rb = Epi::PERM ? ((R & ~31) + perm32(R & 31)) : R;
        voffA[i] = (unsigned)(R * K + C) * 2u; voffB[i] = (unsigned)(Rb * K + C) * 2u; }
    const size_t kstep = (size_t)(BK * 2);
    const size_t hstep = (size_t)HALF * K * 2;
    const size_t tstep = 2 * hstep;
    const unsigned ldsw = (unsigned)wid * 1024u;
    const int aoff = lds_byte(wr * 64 + fr, fq * 8), boff = lds_byte(wc * 32 + fr, fq * 8);
#define PG8_SA(b, h) (((b) * 2 + (h)) * HTB)
#define PG8_SB(b, h) ((4 + (b) * 2 + (h)) * HTB)
#define PG8_STAGE(bufoff, gbase, voff) do { _Pragma("unroll") for (int _i = 0; _i < 2; ++_i) \
        __builtin_amdgcn_global_load_lds((const unsigned*)((const char*)(gbase) + (voff)[_i]), (PG8_LAS unsigned*)(lds + (bufoff) + ldsw + _i * 8192), 16, 0, 0); } while (0)
#define PG8_LDA(dst, b, h) do { _Pragma("unroll") for (int m = 0; m < 4; ++m) _Pragma("unroll") for (int k = 0; k < 2; ++k) dst[m][k] = *(const PG8_LAS bf16x8*)(lds + PG8_SA(b, h) + aoff + m * 2048 + k * 1024); } while (0)
#define PG8_LDB(dst, b, h) do { _Pragma("unroll") for (int n = 0; n < 2; ++n) _Pragma("unroll") for (int k = 0; k < 2; ++k) dst[n][k] = *(const PG8_LAS bf16x8*)(lds + PG8_SB(b, h) + boff + n * 2048 + k * 1024); } while (0)
#define PG8_MMA(ai, bj, At, Bt) do { __builtin_amdgcn_s_setprio(1); _Pragma("unroll") for (int m = 0; m < 4; ++m) _Pragma("unroll") for (int n = 0; n < 2; ++n) _Pragma("unroll") for (int k = 0; k < 2; ++k) \
        acc[ai][bj][m][n] = __builtin_amdgcn_mfma_f32_16x16x32_bf16(Bt[n][k], At[m][k], acc[ai][bj][m][n], 0, 0, 0); __builtin_amdgcn_s_setprio(0); } while (0)
#define PG8_WAIT_V(n) asm volatile("s_waitcnt vmcnt(" #n ")" ::: "memory")
#define PG8_WAIT_L(n) asm volatile("s_waitcnt lgkmcnt(" #n ")" ::: "memory")
#define PG8_BAR __builtin_amdgcn_s_barrier()
#define PG8_SCHED __builtin_amdgcn_sched_barrier(0)
    Unit cur, nxt; int ui = 0;
    if (!S.next(0, cur)) return;
    f32x4 acc[2][2][4][2];
#pragma unroll
    for (int a = 0; a < 2; ++a)
#pragma unroll
        for (int b = 0; b < 2; ++b)
#pragma unroll
            for (int m = 0; m < 4; ++m)
#pragma unroll
                for (int n = 0; n < 2; ++n) acc[a][b][m][n] = (f32x4){0.f, 0.f, 0.f, 0.f};
    bf16x8 At[4][2], B0[2][2], B1[2][2];
    const char* cA = (const char*)g.A + (size_t)cur.pm * tstep; const char* cB = (const char*)g.Bt + (size_t)cur.pn * tstep;
    S.a_ready(cur);
    if constexpr (SP2) {
        PG8_STAGE(PG8_SB(0, 0), cB, voffB); PG8_STAGE(PG8_SB(0, 1), cB + hstep, voffB); PG8_STAGE(PG8_SA(0, 0), cA, voffA); PG8_STAGE(PG8_SA(0, 1), cA + hstep, voffA);
        if (wr == 1) PG8_BAR;
        PG8_WAIT_V(2); PG8_BAR;
        PG8_STAGE(PG8_SB(1, 0), cB + kstep, voffB); PG8_STAGE(PG8_SA(1, 0), cA + kstep, voffA); PG8_STAGE(PG8_SB(1, 1), cB + hstep + kstep, voffB);
        PG8_WAIT_V(6); PG8_BAR;
    } else {
        PG8_STAGE(PG8_SB(0, 0), cB, voffB); PG8_STAGE(PG8_SA(0, 0), cA, voffA); PG8_STAGE(PG8_SB(0, 1), cB + hstep, voffB); PG8_STAGE(PG8_SA(0, 1), cA + hstep, voffA);
        if (wr == 1) PG8_BAR;
        PG8_WAIT_V(4); PG8_BAR;
        PG8_STAGE(PG8_SB(1, 0), cB + kstep, voffB); PG8_STAGE(PG8_SA(1, 0), cA + kstep, voffA); PG8_STAGE(PG8_SB(1, 1), cB + hstep + kstep, voffB);
        PG8_WAIT_V(6); PG8_BAR;
    }
    for (;;) {
        const bool has_next = S.next(ui + 1, nxt);
        const char* nA = has_next ? (const char*)g.A + (size_t)nxt.pm * tstep : cA; const char* nB = has_next ? (const char*)g.Bt + (size_t)nxt.pn * tstep : cB;
        for (int t = 0; t < nt; t += 2) {
            const bool last = (t == nt - 2);
            const char* a1 = cA + (size_t)(t + 1) * kstep;
            const char* a2 = last ? nA : cA + (size_t)(t + 2) * kstep; const char* b2 = last ? nB : cB + (size_t)(t + 2) * kstep;
            const char* a3 = a2 + kstep; const char* b3 = b2 + kstep;
            if (last && has_next) S.a_ready(nxt);
            if constexpr (SP2) {
            PG8_LDB(B0, 0, 0); PG8_LDB(B1, 0, 1); PG8_SCHED; PG8_LDA(At, 0, 0); PG8_STAGE(PG8_SA(1, 1), a1 + hstep, voffA);
            PG8_WAIT_V(8); PG8_WAIT_L(0); PG8_BAR; PG8_MMA(0, 0, At, B0); PG8_MMA(0, 1, At, B1); PG8_BAR; PG8_SCHED;
            PG8_LDA(At, 0, 1); PG8_STAGE(PG8_SB(0, 0), b2, voffB); PG8_STAGE(PG8_SB(0, 1), b2 + hstep, voffB); PG8_STAGE(PG8_SA(0, 0), a2, voffA);
            PG8_WAIT_V(8); PG8_WAIT_L(0); PG8_BAR; PG8_MMA(1, 0, At, B0); PG8_MMA(1, 1, At, B1); PG8_BAR; PG8_SCHED;
            PG8_LDB(B0, 1, 0); PG8_LDB(B1, 1, 1); PG8_SCHED; PG8_LDA(At, 1, 0); PG8_STAGE(PG8_SA(0, 1), a2 + hstep, voffA);
            PG8_WAIT_V(8); PG8_WAIT_L(0); PG8_BAR; PG8_MMA(0, 0, At, B0); PG8_MMA(0, 1, At, B1); PG8_BAR; PG8_SCHED;
            PG8_LDA(At, 1, 1); PG8_STAGE(PG8_SB(1, 0), b3, voffB); PG8_STAGE(PG8_SB(1, 1), b3 + hstep, voffB); PG8_STAGE(PG8_SA(1, 0), a3, voffA);
            PG8_WAIT_V(8); PG8_WAIT_L(0); PG8_BAR; PG8_MMA(1, 0, At, B0); PG8_MMA(1, 1, At, B1); PG8_BAR; PG8_SCHED;
            } else {
            PG8_LDB(B0, 0, 0); PG8_SCHED; PG8_LDA(At, 0, 0); PG8_STAGE(PG8_SA(1, 1), a1 + hstep, voffA);
            PG8_WAIT_L(8); PG8_BAR; PG8_WAIT_L(0); PG8_MMA(0, 0, At, B0); PG8_BAR; PG8_SCHED;
            PG8_LDB(B1, 0, 1); PG8_STAGE(PG8_SB(0, 0), b2, voffB);
            PG8_BAR; PG8_WAIT_L(0); PG8_MMA(0, 1, At, B1); PG8_BAR;
            PG8_LDA(At, 0, 1); PG8_STAGE(PG8_SA(0, 0), a2, voffA);
            PG8_BAR; PG8_WAIT_L(0); PG8_MMA(1, 0, At, B0); PG8_BAR; PG8_SCHED;
            PG8_STAGE(PG8_SB(0, 1), b2 + hstep, voffB);
            PG8_WAIT_V(6); PG8_BAR; PG8_MMA(1, 1, At, B1); PG8_BAR;
            PG8_LDB(B0, 1, 0); PG8_SCHED; PG8_LDA(At, 1, 0); PG8_STAGE(PG8_SA(0, 1), a2 + hstep, voffA);
            PG8_WAIT_L(8); PG8_BAR; PG8_WAIT_L(0); PG8_MMA(0, 0, At, B0); PG8_BAR; PG8_SCHED;
            PG8_LDB(B1, 1, 1); PG8_STAGE(PG8_SB(1, 0), b3, voffB);
            PG8_BAR; PG8_WAIT_L(0); PG8_MMA(0, 1, At, B1); PG8_BAR;
            PG8_LDA(At, 1, 1); PG8_STAGE(PG8_SA(1, 0), a3, voffA);
            PG8_BAR; PG8_WAIT_L(0); PG8_MMA(1, 0, At, B0); PG8_BAR; PG8_SCHED;
            PG8_STAGE(PG8_SB(1, 1), b3 + hstep, voffB);
            PG8_WAIT_V(6); PG8_BAR; PG8_MMA(1, 1, At, B1); PG8_BAR;
            }
        }
        if constexpr (ALIGN_EPI) { if (wr == 0) PG8_BAR; }
        if constexpr (!Epi::AFTER_DRAIN) { E(acc, cur, wr, wc, fr, fq); S.done(cur); }
        if (!has_next) break;
#pragma unroll
        for (int a = 0; a < 2; ++a)
#pragma unroll
            for (int b = 0; b < 2; ++b)
#pragma unroll
                for (int m = 0; m < 4; ++m)
#pragma unroll
                    for (int n = 0; n < 2; ++n) acc[a][b][m][n] = (f32x4){0.f, 0.f, 0.f, 0.f};
        cur = nxt; cA = nA; cB = nB; ++ui;
        if constexpr (ALIGN_EPI) { if (wr == 1) PG8_BAR; }
    }
    PG8_WAIT_V(0);
    if constexpr (!ALIGN_EPI) { if (wr == 0) PG8_BAR; }
    PG8_BAR;
    if constexpr (Epi::AFTER_DRAIN) { E.fused(acc, cur, wr, wc, fr, fq, lds, wid, lane); S.done(cur); }
#undef PG8_SA
#undef PG8_SB
#undef PG8_STAGE
#undef PG8_LDA
#undef PG8_LDB
#undef PG8_MMA
#undef PG8_WAIT_V
#undef PG8_WAIT_L
#undef PG8_BAR
#undef PG8_SCHED
}
}
namespace pg8 {
struct EpiProjRaw {
    static constexpr bool PERM = true, AFTER_DRAIN = false;
    bf16_t* O; int ldc;
    __device__ __forceinline__ void operator()(const f32x4 (&acc)[2][2][4][2], const Unit& u, int wr, int wc, int fr, int fq) const {
        const int row0 = u.pm * BM + wr * 64 + fr; const int col0 = u.pn * BM + wc * 32 + 8 * fq;
#pragma unroll
        for (int ai = 0; ai < 2; ++ai)
#pragma unroll
            for (int m = 0; m < 4; ++m) { bf16_t* rowp = O + (size_t)(row0 + ai * HALF + m * 16) * ldc + col0;
#pragma unroll
                for (int bj = 0; bj < 2; ++bj) { const f32x4 v0 = acc[ai][bj][m][0], v1 = acc[ai][bj][m][1];
                    u32x4 w; w.x = cvt_pk_bf16(v0[0], v0[1]); w.y = cvt_pk_bf16(v0[2], v0[3]); w.z = cvt_pk_bf16(v1[0], v1[1]); w.w = cvt_pk_bf16(v1[2], v1[3]);
                    *(u32x4*)(rowp + bj * HALF) = w; } }
    }
};
struct EpiOut {
    static constexpr bool PERM = false, AFTER_DRAIN = false;
    const float* X; float* Out; float* SSQ;
    __device__ __forceinline__ void operator()(const f32x4 (&acc)[2][2][4][2], const Unit& u, int wr, int wc, int fr, int fq) const {
        const int col0 = u.pn * BM + wc * 32 + 4 * fq;
#pragma unroll
        for (int ai = 0; ai < 2; ++ai)
#pragma unroll
            for (int m = 0; m < 4; ++m) { const int r = u.pm * BM + ai * HALF + wr * 64 + m * 16 + fr; const size_t off = (size_t)r * 1024 + col0; float ss = 0.f;
#pragma unroll
                for (int bj = 0; bj < 2; ++bj)
#pragma unroll
                    for (int n = 0; n < 2; ++n) { const f32x4 xv = *(const f32x4*)(X + off + bj * HALF + n * 16); const f32x4 o = xv + acc[ai][bj][m][n];
                        *(f32x4*)(Out + off + bj * HALF + n * 16) = o; ss += (o[0] * o[0] + o[1] * o[1]) + (o[2] * o[2] + o[3] * o[3]); }
                ss += __shfl_xor(ss, 16); ss += __shfl_xor(ss, 32);
                if (fq == 0) SSQ[(size_t)r * 16 + u.pn * 4 + wc] = ss; }
    }
};
}
#define GAS __attribute__((address_space(1)))
#define LAS __attribute__((address_space(3)))
typedef unsigned short bf16;
typedef unsigned v4u __attribute__((ext_vector_type(4)));
typedef float f32x4 __attribute__((ext_vector_type(4)));
typedef short bf16x8 __attribute__((ext_vector_type(8)));
typedef GAS unsigned gu32;
typedef GAS unsigned long long gu64;
#define RLX_AGENT __ATOMIC_RELAXED, __HIP_MEMORY_SCOPE_AGENT
#define LDS_WAIT() asm volatile("s_waitcnt lgkmcnt(0)" ::: "memory")
#define VM_WAIT() asm volatile("s_waitcnt vmcnt(0)" ::: "memory")
__device__ __forceinline__ unsigned long long rt() { return __builtin_amdgcn_s_memrealtime(); }
__device__ __forceinline__ unsigned f2bf(float f) { unsigned u = __builtin_bit_cast(unsigned, f); return (u + 0x7fffu + ((u >> 16) & 1u)) >> 16; }
__device__ __forceinline__ unsigned pk2(float lo, float hi) { return f2bf(lo) | (f2bf(hi) << 16); }
#define XB_TMO      128
#define XB_XCNT(j)  (256  + 64 * (j))
#define XB_XSUB(j)  (1280 + 64 * (j))
#define XB_XGEN(j)  (2304 + 64 * (j))
#define XB_TOP      3328
#define XB_TOPGEN   3392
#define XCD_BAR_WORDS 3456
#define XB_SPIN_CAP (1u << 18)

__device__ __forceinline__ unsigned xb_ld(unsigned* p)              { return __hip_atomic_load(p, __ATOMIC_RELAXED, __HIP_MEMORY_SCOPE_AGENT); }
__device__ __forceinline__ unsigned xb_add(unsigned* p, unsigned v) { return __hip_atomic_fetch_add(p, v, __ATOMIC_RELAXED, __HIP_MEMORY_SCOPE_AGENT); }
__device__ __forceinline__ unsigned xb_xcc_id() { return (unsigned)__builtin_amdgcn_s_getreg((3 << 11) | 20) & 0xFu; }
#define XB_SPIN(cond, bar) do { unsigned _sp = 0; while (cond) { __builtin_amdgcn_s_sleep(1); \
    if ((++_sp & 255u) == 0u) { if (xb_ld(&(bar)[XB_TMO])) break; if (_sp > XB_SPIN_CAP) { atomicAdd(&(bar)[XB_TMO], 1u); break; } } } } while (0)

struct XcdBarrier {
    unsigned* bar; unsigned x;
    volatile LAS unsigned* st;
};

__device__ __forceinline__ XcdBarrier xcd_barrier_post(unsigned* bar, volatile LAS unsigned* st) {
    XcdBarrier b; b.bar = bar; b.x = xb_xcc_id(); b.st = st;
    if (threadIdx.x == 0) (void)xb_add(&bar[XB_XCNT(b.x)], 1u);
    return b;
}
__device__ __forceinline__ void xcd_barrier_complete(unsigned* bar, unsigned x, unsigned& nloc, unsigned& nx) {
    const unsigned G = gridDim.x * gridDim.y * gridDim.z;
    unsigned sum, cnt, mine, sp = 0u;
    for (;;) {
        sum = 0u; cnt = 0u; mine = 0u;
#pragma unroll
        for (unsigned j = 0; j < 16; ++j) { const unsigned c = xb_ld(&bar[XB_XCNT(j)]); sum += c; cnt += (c > 0u) ? 1u : 0u; mine = (j == x) ? c : mine; }
        if (sum == G) break;
        __builtin_amdgcn_s_sleep(1);
        if ((++sp & 255u) == 0u) { if (xb_ld(&bar[XB_TMO])) break; if (sp > XB_SPIN_CAP) { atomicAdd(&bar[XB_TMO], 1u); break; } }
    }
    nloc = mine > 0u ? mine : 1u; nx = cnt > 0u ? cnt : 1u;
}

__device__ __forceinline__ void xcd_barrier(const XcdBarrier& b) {
    asm volatile("s_waitcnt vmcnt(0)" ::: "memory");
    __syncthreads();
    if (threadIdx.x == 0) {
        unsigned* bar = b.bar;
        __builtin_amdgcn_s_waitcnt(0);
        unsigned nloc = b.st[0], nx = b.st[1];
        if (nloc == 0u) { xcd_barrier_complete(bar, b.x, nloc, nx); b.st[0] = nloc; b.st[1] = nx; }
        const unsigned old = xb_add(&bar[XB_XSUB(b.x)], 1u);
        const unsigned gen = old / nloc;
        if (old + 1u == (gen + 1u) * nloc) {
            __builtin_amdgcn_fence(__ATOMIC_RELEASE, "agent");
            asm volatile("s_waitcnt vmcnt(0)" ::: "memory");
            const unsigned og = xb_add(&bar[XB_TOP], 1u);
            const unsigned tg = og / nx;
            if (og + 1u == (tg + 1u) * nx) xb_add(&bar[XB_TOPGEN], 1u);
            else XB_SPIN(xb_ld(&bar[XB_TOPGEN]) == tg, bar);
            __builtin_amdgcn_fence(__ATOMIC_ACQUIRE, "agent");
            xb_add(&bar[XB_XGEN(b.x)], 1u);
            asm volatile("s_waitcnt vmcnt(0)" ::: "memory");
        } else {
            XB_SPIN(xb_ld(&bar[XB_XGEN(b.x)]) == gen, bar);
            __builtin_amdgcn_fence(__ATOMIC_ACQUIRE, "agent");
            asm volatile("s_waitcnt vmcnt(0)" ::: "memory");
        }
    }
    __syncthreads();
}
constexpr int NWAVES = 8;
constexpr int BATCH = 8, SEQ = 4096, DMODEL = 1024, T = BATCH * SEQ, INC = 4096;
constexpr float NORM_EPS = 1e-6f;
constexpr size_t MiB = 1u << 20;
constexpr size_t WS_CTL = 0, CTL_ZERO_BYTES = 1 * MiB;
constexpr size_t WS_WIN = 2 * MiB, WS_WOUT = 10 * MiB, WS_SSQ = 12 * MiB;
constexpr size_t WS_PROJ = 16 * MiB;
constexpr size_t WS_XN = 272 * MiB;
constexpr size_t WS_MIXED = 336 * MiB;
constexpr size_t WS_KR = 400 * MiB, WS_HQS = 432 * MiB, WS_QR = 464 * MiB, WS_END = 496 * MiB;
constexpr int CW_BAR = 4096;
constexpr int RING_OFF = 0, RING_BYTES = 131072;
constexpr int LDSCTL_OFF = RING_BYTES, MISC_OFF = LDSCTL_OFF + 320;
constexpr int LDS_BYTES = 147456;

__device__ __forceinline__ float bf2f(unsigned short u) { return __uint_as_float(((unsigned)u) << 16); }
__device__ __forceinline__ float sigmoidf_(float x) { return 1.0f / (1.0f + __expf(-x)); }
__device__ __forceinline__ float wave_sum(float v) {
#pragma unroll
    for (int o = 1; o < 64; o <<= 1) v += __shfl_xor(v, o);
    return v;
}
__device__ __forceinline__ float wave_max(float v) {
#pragma unroll
    for (int o = 1; o < 64; o <<= 1) v = fmaxf(v, __shfl_xor(v, o));
    return v;
}
__device__ __forceinline__ float inv_freq(int i) {
    return i == 0 ? 1.0f : i == 1 ? 0.19392274474868576f : i == 2 ? 0.03760603093086393f : i == 3 ? 0.007292664737217109f :
           i == 4 ? 0.001414213562373095f : i == 5 ? 0.0002742481756762073f : i == 6 ? 5.318295896944988e-05f : 1.031338537721246e-05f;
}

struct Args { const float* x; const int* pos; const float* w_in; const float* w_out; const float* mix_w; const float* attn_w; const float* hgrn_w; const float* lb_raw; const float* fin_w; float* out; unsigned char* ws; };

__device__ __forceinline__ void p0_transpose_item(const float* W, int K, int N, bf16* WT, const float* gain, LAS float* scr, int item, int lane) {
    const int nblk = N / 32, kb = item / nblk, nb = item % nblk, k0 = 64 * kb, n0 = 32 * nb;
#pragma unroll 8
    for (int i = 0; i < 32; ++i) { const int kk = 2 * i + (lane >> 5); float w = W[(size_t)(k0 + kk) * N + n0 + (lane & 31)]; if (gain) w *= gain[k0 + kk]; scr[kk * 33 + (lane & 31)] = w; }
    LDS_WAIT(); asm volatile("" ::: "memory");
    const int c = lane & 7;
#pragma unroll
    for (int j = 0; j < 4; ++j) { const int n = (lane >> 3) + 8 * j; const LAS float* s = scr + (8 * c) * 33 + n;
        v4u o; o.x = pk2(s[0 * 33], s[1 * 33]); o.y = pk2(s[2 * 33], s[3 * 33]); o.z = pk2(s[4 * 33], s[5 * 33]); o.w = pk2(s[6 * 33], s[7 * 33]);
        *(GAS v4u*)(WT + (size_t)(n0 + n) * K + k0 + 8 * c) = o; }
    LDS_WAIT(); asm volatile("" ::: "memory");
}

__global__ void __launch_bounds__(NWAVES * 64, 2) fwd_kernel(Args A) {
    extern __shared__ __attribute__((aligned(16))) unsigned char lds[];
    LAS unsigned char* L = (LAS unsigned char*)lds;
    volatile LAS unsigned* MISC = (volatile LAS unsigned*)(L + MISC_OFF);
    const int tid = threadIdx.x, lane = tid & 63, wave = __builtin_amdgcn_readfirstlane(tid >> 6);
    const int G = gridDim.x, bx = blockIdx.x;
    const int vcu = (G % 8 == 0) ? (bx % 8) * (G / 8) + bx / 8 : bx;
    unsigned char* ws = A.ws;
    gu32* ctl = (gu32*)(ws + WS_CTL);
    bf16* WinT = (bf16*)(ws + WS_WIN); bf16* WoT = (bf16*)(ws + WS_WOUT); float* SSQ = (float*)(ws + WS_SSQ);
    bf16* PROJ = (bf16*)(ws + WS_PROJ); bf16* XN = (bf16*)(ws + WS_XN); float* F32 = (float*)(ws + WS_XN);
    bf16* MIXED = (bf16*)(ws + WS_MIXED); bf16* KR = (bf16*)(ws + WS_KR); bf16* HQS = (bf16*)(ws + WS_HQS); bf16* QR = (bf16*)(ws + WS_QR);
    for (int u = tid; u < (LDS_BYTES - LDSCTL_OFF) / 4; u += NWAVES * 64) ((LAS unsigned*)(L + LDSCTL_OFF))[u] = 0u;
    __syncthreads();
    XcdBarrier bar = xcd_barrier_post((unsigned*)(ctl + CW_BAR), MISC + 8);
    const int gw = vcu * NWAVES + wave, NGW = G * NWAVES;

    {
        LAS float* scr = (LAS float*)(L + RING_OFF + wave * 16384);
        constexpr int I_IN = (DMODEL / 64) * (INC / 32), I_OUT = (DMODEL / 64) * (DMODEL / 32);
        for (int it = gw; it < I_IN + I_OUT; it += NGW) {
            if (it < I_IN) p0_transpose_item(A.w_in, DMODEL, INC, WinT, A.mix_w, scr, it, lane);
            else p0_transpose_item(A.w_out, DMODEL, DMODEL, WoT, nullptr, scr, it - I_IN, lane);
        }
        for (int m = gw; m < T; m += NGW) {
            const GAS f32x4* xr = (const GAS f32x4*)(A.x + (size_t)m * DMODEL) + lane;
            f32x4 v[4]; float s = 0.f;
#pragma unroll
            for (int j = 0; j < 4; ++j) { v[j] = xr[64 * j]; s += (v[j].x * v[j].x + v[j].y * v[j].y) + (v[j].z * v[j].z + v[j].w * v[j].w); }
            const float rstd = 1.f / sqrtf(wave_sum(s) * (1.f / DMODEL) + NORM_EPS);
            GAS unsigned long long* o8 = (GAS unsigned long long*)(XN + (size_t)m * DMODEL) + lane;
#pragma unroll
            for (int j = 0; j < 4; ++j) o8[64 * j] = (unsigned long long)pk2(v[j].x * rstd, v[j].y * rstd) | ((unsigned long long)pk2(v[j].z * rstd, v[j].w * rstd) << 32);
        }
    }
    xcd_barrier(bar);
    {
        pg8::Gemm g{XN, WinT, T, INC, DMODEL}; pg8::StaticOrder S; S.init(T, INC, G, bx);
        pg8::EpiProjRaw E{PROJ, INC};
        pg8::gemm_phase<pg8::EpiProjRaw, pg8::StaticOrder, true, true>(L + RING_OFF, g, S, E);
    }
    xcd_barrier(bar);
    for (int tok = bx; tok < T; tok += G) {
        const int c = tid; const bf16* pr = PROJ + (size_t)tok * INC; const int d = c & 63;
        float qv = bf2f(pr[c]), kv = bf2f(pr[512 + c]);
        if (d < 16) {
            const float ang = (float)A.pos[tok] * inv_freq(d & 7); float sn, cs; sincosf(ang, &sn, &cs);
            const int pc = (d < 8) ? c + 8 : c - 8; const float qp = bf2f(pr[pc]), kp = bf2f(pr[512 + pc]);
            if (d < 8) { qv = qv * cs - qp * sn; kv = kv * cs - kp * sn; } else { qv = qv * cs + qp * sn; kv = kv * cs + kp * sn; }
        }
        QR[(size_t)tok * 512 + c] = (bf16)f2bf(qv); KR[(size_t)tok * 512 + c] = (bf16)f2bf(kv);
        const float hq = bf2f(pr[2048 + c]); HQS[(size_t)tok * 512 + c] = (bf16)f2bf(hq * sigmoidf_(hq));
        const float hf = bf2f(pr[2560 + c]); const float lb = 1.0f / (1.0f + __expf(A.lb_raw[512 + c] - A.lb_raw[c]));
        F32[(size_t)tok * 512 + c] = lb + (1.0f - lb) * sigmoidf_(hf);
    }
    xcd_barrier(bar);
    if (bx < 8) {
        const int g = tid >> 7, v = tid & 127, bh = bx * 4 + g, b = bh >> 2, h = bh & 3;
        float S[128];
#pragma unroll
        for (int e = 0; e < 128; ++e) S[e] = 0.f;
        LAS float* red = (LAS float*)(L + RING_OFF);
        const float wn = A.hgrn_w[h * 128 + v];
        for (int t = 0; t < SEQ; ++t) {
            const size_t tok = (size_t)b * SEQ + t;
            const GAS f32x4* fp = (const GAS f32x4*)(F32 + tok * 512 + h * 128);
            const GAS v4u* qp = (const GAS v4u*)(HQS + tok * 512 + h * 128);
            const float vv = bf2f(PROJ[tok * INC + 3072 + h * 128 + v]);
            float o = 0.f;
#pragma unroll
            for (int e8 = 0; e8 < 16; ++e8) {
                const v4u qq = qp[e8]; const f32x4 f0 = fp[2 * e8], f1 = fp[2 * e8 + 1];
                const float q0 = __uint_as_float(qq.x << 16), q1 = __uint_as_float(qq.x & 0xffff0000u), q2 = __uint_as_float(qq.y << 16), q3 = __uint_as_float(qq.y & 0xffff0000u);
                const float q4 = __uint_as_float(qq.z << 16), q5 = __uint_as_float(qq.z & 0xffff0000u), q6 = __uint_as_float(qq.w << 16), q7 = __uint_as_float(qq.w & 0xffff0000u);
                float s;
                s = f0.x * S[8 * e8 + 0] + (1.f - f0.x) * vv; S[8 * e8 + 0] = s; o += q0 * s;
                s = f0.y * S[8 * e8 + 1] + (1.f - f0.y) * vv; S[8 * e8 + 1] = s; o += q1 * s;
                s = f0.z * S[8 * e8 + 2] + (1.f - f0.z) * vv; S[8 * e8 + 2] = s; o += q2 * s;
                s = f0.w * S[8 * e8 + 3] + (1.f - f0.w) * vv; S[8 * e8 + 3] = s; o += q3 * s;
                s = f1.x * S[8 * e8 + 4] + (1.f - f1.x) * vv; S[8 * e8 + 4] = s; o += q4 * s;
                s = f1.y * S[8 * e8 + 5] + (1.f - f1.y) * vv; S[8 * e8 + 5] = s; o += q5 * s;
                s = f1.z * S[8 * e8 + 6] + (1.f - f1.z) * vv; S[8 * e8 + 6] = s; o += q6 * s;
                s = f1.w * S[8 * e8 + 7] + (1.f - f1.w) * vv; S[8 * e8 + 7] = s; o += q7 * s;
            }
            const float w2 = wave_sum(o * o);
            if (lane == 0) red[(t & 1) * 8 + wave] = w2;
            __syncthreads();
            const float ss = red[(t & 1) * 8 + (wave & ~1)] + red[(t & 1) * 8 + (wave | 1)];
            const float hg = bf2f(PROJ[tok * INC + 3584 + h * 128 + v]);
            const float y = o * (1.0f / sqrtf(ss * (1.0f / 128.0f) + NORM_EPS)) * wn * (hg * sigmoidf_(hg));
            MIXED[tok * DMODEL + 512 + h * 128 + v] = (bf16)f2bf(y);
        }
    }
    for (int task = gw; task < BATCH * 8 * SEQ; task += NGW) {
        const int bh = task / SEQ, t = task % SEQ, b = bh >> 3, h = bh & 7;
        const size_t tokq = (size_t)b * SEQ + t;
        float qf[64];
        { const GAS v4u* qp = (const GAS v4u*)(QR + tokq * 512 + h * 64);
#pragma unroll
          for (int i = 0; i < 8; ++i) { const v4u q = qp[i];
              qf[8 * i + 0] = __uint_as_float(q.x << 16); qf[8 * i + 1] = __uint_as_float(q.x & 0xffff0000u); qf[8 * i + 2] = __uint_as_float(q.y << 16); qf[8 * i + 3] = __uint_as_float(q.y & 0xffff0000u);
              qf[8 * i + 4] = __uint_as_float(q.z << 16); qf[8 * i + 5] = __uint_as_float(q.z & 0xffff0000u); qf[8 * i + 6] = __uint_as_float(q.w << 16); qf[8 * i + 7] = __uint_as_float(q.w & 0xffff0000u); } }
        float sc[7]; float mx = -1e30f;
#pragma unroll
        for (int r = 0; r < 7; ++r) {
            const int idx = lane + 64 * r; const int p = idx / 129, j = idx - 129 * p; const int dl = (p == 0) ? 1 : (p == 1) ? 4 : 16; const int tk = t - dl * j;
            float s = -1e30f;
            if (idx < 387 && tk >= 0) {
                const GAS v4u* kp = (const GAS v4u*)(KR + ((size_t)b * SEQ + tk) * 512 + h * 64); float dot = 0.f;
#pragma unroll
                for (int i = 0; i < 8; ++i) { const v4u k = kp[i];
                    dot += qf[8 * i + 0] * __uint_as_float(k.x << 16) + qf[8 * i + 1] * __uint_as_float(k.x & 0xffff0000u) + qf[8 * i + 2] * __uint_as_float(k.y << 16) + qf[8 * i + 3] * __uint_as_float(k.y & 0xffff0000u)
                         + qf[8 * i + 4] * __uint_as_float(k.z << 16) + qf[8 * i + 5] * __uint_as_float(k.z & 0xffff0000u) + qf[8 * i + 6] * __uint_as_float(k.w << 16) + qf[8 * i + 7] * __uint_as_float(k.w & 0xffff0000u); }
                s = dot * 0.125f;
            }
            sc[r] = s; mx = fmaxf(mx, s);
        }
        mx = wave_max(mx);
        float lsum = 0.f;
#pragma unroll
        for (int r = 0; r < 7; ++r) { sc[r] = (sc[r] > -1e29f) ? __expf(sc[r] - mx) : 0.f; lsum += sc[r]; }
        lsum = wave_sum(lsum);
        float o = 0.f;
        const bf16* vbase = PROJ + (size_t)b * SEQ * INC + 1024 + h * 64 + lane;
#pragma unroll
        for (int r = 0; r < 7; ++r) {
            for (int l2 = 0; l2 < 64; ++l2) {
                const int idx = l2 + 64 * r; if (idx >= 387) break;
                const int p = idx / 129, j = idx - 129 * p; const int dl = (p == 0) ? 1 : (p == 1) ? 4 : 16; const int tk = t - dl * j;
                const float pv = __int_as_float(__builtin_amdgcn_readlane(__float_as_int(sc[r]), l2));
                if (tk >= 0) o += pv * bf2f(vbase[(size_t)tk * INC]);
            }
        }
        const float at = o / lsum;
        const float ss = wave_sum(at * at);
        const float ag = bf2f(PROJ[tokq * INC + 1536 + h * 64 + lane]);
        const float y = at * (1.0f / sqrtf(ss * (1.0f / 64.0f) + NORM_EPS)) * A.attn_w[h * 64 + lane] * (ag * sigmoidf_(ag));
        MIXED[tokq * DMODEL + h * 64 + lane] = (bf16)f2bf(y);
    }
    xcd_barrier(bar);
    {
        pg8::Gemm g{MIXED, WoT, T, DMODEL, DMODEL}; pg8::StaticOrder S; S.init(T, DMODEL, G, bx);
        pg8::EpiOut E{A.x, A.out, SSQ};
        pg8::gemm_phase<pg8::EpiOut, pg8::StaticOrder, true, true>(L + RING_OFF, g, S, E);
    }
    xcd_barrier(bar);
    for (int m = gw; m < T; m += NGW) {
        float s = (lane < 16) ? SSQ[(size_t)m * 16 + lane] : 0.f; s = wave_sum(s);
        const float rstd = 1.f / sqrtf(s * (1.f / DMODEL) + NORM_EPS);
        GAS f32x4* xr = (GAS f32x4*)(A.out + (size_t)m * DMODEL) + lane; const GAS f32x4* wr_ = (const GAS f32x4*)A.fin_w + lane;
#pragma unroll
        for (int j = 0; j < 4; ++j) { f32x4 v = xr[64 * j]; const f32x4 w = wr_[64 * j]; v = v * rstd * w; xr[64 * j] = v; }
    }
}

extern "C" void kernel_launch(void* const* d_in, const int* in_sizes, int n_in, void* d_out, int out_size, void* d_ws, size_t ws_size, hipStream_t stream) {
    static int grid = 0;
    if (grid == 0) {
        if (n_in != 9 || in_sizes[0] != T * DMODEL || out_size != T * DMODEL || ws_size < WS_END) { fprintf(stderr, "kernel_launch: unexpected shapes/ws (n_in %d, ws %zu)\n", n_in, ws_size); grid = -1; return; }
        int dev = 0, cus = 0, per_cu = 0;
        if (hipGetDevice(&dev) != hipSuccess || hipDeviceGetAttribute(&cus, hipDeviceAttributeMultiprocessorCount, dev) != hipSuccess) { grid = -1; return; }
        if (hipFuncSetAttribute((const void*)fwd_kernel, hipFuncAttributeMaxDynamicSharedMemorySize, LDS_BYTES) != hipSuccess) { fprintf(stderr, "kernel_launch: hipFuncSetAttribute failed\n"); grid = -1; return; }
        if (hipOccupancyMaxActiveBlocksPerMultiprocessor(&per_cu, (const void*)fwd_kernel, NWAVES * 64, LDS_BYTES) != hipSuccess || per_cu < 1) { fprintf(stderr, "kernel_launch: occupancy query says %d blocks/CU\n", per_cu); grid = -1; (void)hipGetLastError(); return; }
        grid = cus;
    }
    if (grid < 0) return;
    (void)hipMemsetAsync((char*)d_ws + WS_CTL, 0, CTL_ZERO_BYTES, stream);
    Args a{};
    a.x = (const float*)d_in[0]; a.pos = (const int*)d_in[1]; a.w_in = (const float*)d_in[2]; a.w_out = (const float*)d_in[3]; a.mix_w = (const float*)d_in[4];
    a.attn_w = (const float*)d_in[5]; a.hgrn_w = (const float*)d_in[6]; a.lb_raw = (const float*)d_in[7]; a.fin_w = (const float*)d_in[8];
    a.out = (float*)d_out; a.ws = (unsigned char*)d_ws;
    hipLaunchKernelGGL(fwd_kernel, dim3(grid), dim3(NWAVES * 64), LDS_BYTES, stream, a);
}
```

```cpp
#include <hip/hip_runtime.h>
#include <cstdio>
#include <cstdint>
namespace pg8 {
#define PG8_LAS __attribute__((address_space(3)))
typedef unsigned short bf16_t;
typedef short bf16x8 __attribute__((ext_vector_type(8)));
typedef float f32x4 __attribute__((ext_vector_type(4)));
typedef unsigned u32x4 __attribute__((ext_vector_type(4)));
constexpr int BM = 256, BK = 64, HALF = 128, HTB = HALF * BK * 2  , STAGE_BYTES = 8 * HTB, NXCD = 8, WGM = 8;

__host__ __device__ __forceinline__ int lds_byte(int r, int c) { const int st = (r >> 4) * 2 + (c >> 5), rr = r & 15, cc = c & 31, ob = rr * 64 + cc * 2; return st * 1024 + (ob ^ (((ob >> 9) & 1) << 5)); }
__host__ __device__ __forceinline__ void stage_rc(int b, int& R, int& C) { const int st = b / 1024, sb = b % 1024, swz = sb ^ (((sb >> 9) & 1) << 5); R = (st >> 1) * 16 + swz / 64; C = (st & 1) * 32 + (swz % 64) / 2; }
__host__ __device__ __forceinline__ int perm32(int rho) { const int n = rho >> 4, i = rho & 15; return 8 * (i >> 2) + 4 * n + (i & 3); }

struct Unit { int pm, pn; };
struct Gemm { const bf16_t* A; const bf16_t* Bt; int M, N, K; };

struct StaticOrder {
    int nM, nN, nwg, G, c;
    __host__ __device__ void init(int M, int N, int G_, int c_) { nM = M / BM; nN = N / BM; nwg = nM * nN; G = G_; c = c_; }
    __host__ __device__ bool next(int i, Unit& u) const {
        const long L = (long)i * G + c; if (L >= nwg) return false;
        int wgid = (int)L; { const int q = nwg / NXCD, r = nwg % NXCD, xcd = wgid % NXCD, off = wgid / NXCD; wgid = (xcd < r ? xcd * (q + 1) : r * (q + 1) + (xcd - r) * q) + off; }
        const int nig = WGM * nN, gid = wgid / nig, fm = gid * WGM, gsz = (nM - fm) < WGM ? (nM - fm) : WGM;
        u.pm = fm + ((wgid % nig) % gsz); u.pn = (wgid % nig) / gsz; return true;
    }
    __device__ __forceinline__ void a_ready(const Unit&) const {}
    __device__ __forceinline__ void done(const Unit&) const {}
};

__device__ __forceinline__ unsigned cvt_pk_bf16(float lo, float hi) { unsigned r; asm volatile("v_cvt_pk_bf16_f32 %0, %1, %2" : "=v"(r) : "v"(lo), "v"(hi)); return r; }
typedef float f32x2 __attribute__((ext_vector_type(2)));
template <class Epi, class Sched, bool ALIGN_EPI = false, bool SP2 = false>
__device__ __forceinline__ void gemm_phase(PG8_LAS unsigned char* lds, const Gemm g, const Sched& S, const Epi& E) {
    int tid_ = threadIdx.x; asm volatile("" : "+v"(tid_));
    const int tid = tid_, wid = __builtin_amdgcn_readfirstlane(tid >> 6), lane = tid & 63, wr = wid >> 2, wc = wid & 3, fr = lane & 15, fq = lane >> 4;
    const int K = g.K, nt = K / BK;
    unsigned voffA[2], voffB[2];
#pragma unroll
    for (int i = 0; i < 2; ++i) { int R, C; stage_rc(tid * 16 + i * 8192, R, C); const int Rb = Epi::PERM ? ((R & ~31) + perm32(R & 31)) : R;
        voffA[i] = (unsigned)(R * K + C) * 2u; voffB[i] = (unsigned)(Rb * K + C) * 2u; }
    const size_t kstep = (size_t)(BK * 2);
    const size_t hstep = (size_t)HALF * K * 2;
    const size_t tstep = 2 * hstep;
    const unsigned ldsw = (unsigned)wid * 1024u;
    const int aoff = lds_byte(wr * 64 + fr, fq * 8), boff = lds_byte(wc * 32 + fr, fq * 8);
#define PG8_SA(b, h) (((b) * 2 + (h)) * HTB)
#define PG8_SB(b, h) ((4 + (b) * 2 + (h)) * HTB)
#define PG8_STAGE(bufoff, gbase, voff) do { _Pragma("unroll") for (int _i = 0; _i < 2; ++_i) \
        __builtin_amdgcn_global_load_lds((const unsigned*)((const char*)(gbase) + (voff)[_i]), (PG8_LAS unsigned*)(lds + (bufoff) + ldsw + _i * 8192), 16, 0, 0); } while (0)
#define PG8_LDA(dst, b, h) do { _Pragma("unroll") for (int m = 0; m < 4; ++m) _Pragma("unroll") for (int k = 0; k < 2; ++k) dst[m][k] = *(const PG8_LAS bf16x8*)(lds + PG8_SA(b, h) + aoff + m * 2048 + k * 1024); } while (0)
#define PG8_LDB(dst, b, h) do { _Pragma("unroll") for (int n = 0; n < 2; ++n) _Pragma("unroll") for (int k = 0; k < 2; ++k) dst[n][k] = *(const PG8_LAS bf16x8*)(lds + PG8_SB(b, h) + boff + n * 2048 + k * 1024); } while (0)
#define PG8_MMA(ai, bj, At, Bt) do { __builtin_amdgcn_s_setprio(1); _Pragma("unroll") for (int m = 0; m < 4; ++m) _Pragma("unroll") for (int n = 0; n < 2; ++n) _Pragma("unroll") for (int k = 0; k < 2; ++k) \
        acc[ai][bj][m][n] = __builtin_amdgcn_mfma_f32_16x16x32_bf16(Bt[n][k], At[m][k], acc[ai][bj][m][n], 0, 0, 0); __builtin_amdgcn_s_setprio(0); } while (0)
#define PG8_WAIT_V(n) asm volatile("s_waitcnt vmcnt(" #n ")" ::: "memory")
#define PG8_WAIT_L(n) asm volatile("s_waitcnt lgkmcnt(" #n ")" ::: "memory")
#define PG8_BAR __builtin_amdgcn_s_barrier()
#define PG8_SCHED __builtin_amdgcn_sched_barrier(0)
    Unit cur, nxt; int ui = 0;
    if (!S.next(0, cur)) return;
    f32x4 acc[2][2][4][2];
#pragma unroll
    for (int a = 0; a < 2; ++a)
#pragma unroll
        for (int b = 0; b < 2; ++b)
#pragma unroll
            for (int m = 0; m < 4; ++m)
#pragma unroll
                for (int n = 0; n < 2; ++n) acc[a][b][m][n] = (f32x4){0.f, 0.f, 0.f, 0.f};
    bf16x8 At[4][2], B0[2][2], B1[2][2];
    const char* cA = (const char*)g.A + (size_t)cur.pm * tstep; const char* cB = (const char*)g.Bt + (size_t)cur.pn * tstep;
    S.a_ready(cur);
    if constexpr (SP2) {
        PG8_STAGE(PG8_SB(0, 0), cB, voffB); PG8_STAGE(PG8_SB(0, 1), cB + hstep, voffB); PG8_STAGE(PG8_SA(0, 0), cA, voffA); PG8_STAGE(PG8_SA(0, 1), cA + hstep, voffA);
        if (wr == 1) PG8_BAR;
        PG8_WAIT_V(2); PG8_BAR;
        PG8_STAGE(PG8_SB(1, 0), cB + kstep, voffB); PG8_STAGE(PG8_SA(1, 0), cA + kstep, voffA); PG8_STAGE(PG8_SB(1, 1), cB + hstep + kstep, voffB);
        PG8_WAIT_V(6); PG8_BAR;
    } else {
        PG8_STAGE(PG8_SB(0, 0), cB, voffB); PG8_STAGE(PG8_SA(0, 0), cA, voffA); PG8_STAGE(PG8_SB(0, 1), cB + hstep, voffB); PG8_STAGE(PG8_SA(0, 1), cA + hstep, voffA);
        if (wr == 1) PG8_BAR;
        PG8_WAIT_V(4); PG8_BAR;
        PG8_STAGE(PG8_SB(1, 0), cB + kstep, voffB); PG8_STAGE(PG8_SA(1, 0), cA + kstep, voffA); PG8_STAGE(PG8_SB(1, 1), cB + hstep + kstep, voffB);
        PG8_WAIT_V(6); PG8_BAR;
    }
    for (;;) {
        const bool has_next = S.next(ui + 1, nxt);
        const char* nA = has_next ? (const char*)g.A + (size_t)nxt.pm * tstep : cA; const char* nB = has_next ? (const char*)g.Bt + (size_t)nxt.pn * tstep : cB;
        for (int t = 0; t < nt; t += 2) {
            const bool last = (t == nt - 2);
            const char* a1 = cA + (size_t)(t + 1) * kstep;
            const char* a2 = last ? nA : cA + (size_t)(t + 2) * kstep; const char* b2 = last ? nB : cB + (size_t)(t + 2) * kstep;
            const char* a3 = a2 + kstep; const char* b3 = b2 + kstep;
            if (last && has_next) S.a_ready(nxt);
            if constexpr (SP2) {
            PG8_LDB(B0, 0, 0); PG8_LDB(B1, 0, 1); PG8_SCHED; PG8_LDA(At, 0, 0); PG8_STAGE(PG8_SA(1, 1), a1 + hstep, voffA);
            PG8_WAIT_V(8); PG8_WAIT_L(0); PG8_BAR; PG8_MMA(0, 0, At, B0); PG8_MMA(0, 1, At, B1); PG8_BAR; PG8_SCHED;
            PG8_LDA(At, 0, 1); PG8_STAGE(PG8_SB(0, 0), b2, voffB); PG8_STAGE(PG8_SB(0, 1), b2 + hstep, voffB); PG8_STAGE(PG8_SA(0, 0), a2, voffA);
            PG8_WAIT_V(8); PG8_WAIT_L(0); PG8_BAR; PG8_MMA(1, 0, At, B0); PG8_MMA(1, 1, At, B1); PG8_BAR; PG8_SCHED;
            PG8_LDB(B0, 1, 0); PG8_LDB(B1, 1, 1); PG8_SCHED; PG8_LDA(At, 1, 0); PG8_STAGE(PG8_SA(0, 1), a2 + hstep, voffA);
            PG8_WAIT_V(8); PG8_WAIT_L(0); PG8_BAR; PG8_MMA(0, 0, At, B0); PG8_MMA(0, 1, At, B1); PG8_BAR; PG8_SCHED;
            PG8_LDA(At, 1, 1); PG8_STAGE(PG8_SB(1, 0), b3, voffB); PG8_STAGE(PG8_SB(1, 1), b3 + hstep, voffB); PG8_STAGE(PG8_SA(1, 0), a3, voffA);
            PG8_WAIT_V(8); PG8_WAIT_L(0); PG8_BAR; PG8_MMA(1, 0, At, B0); PG8_MMA(1, 1, At, B1); PG8_BAR; PG8_SCHED;
            } else {
            PG8_LDB(B0, 0, 0); PG8_SCHED; PG8_LDA(At, 0, 0); PG8_STAGE(PG8_SA(1, 1), a1 + hstep, voffA);
            PG8_WAIT_L(8); PG8_BAR; PG8_WAIT_L(0); PG8_MMA(0, 0, At, B0); PG8_BAR; PG8_SCHED;
            PG8_LDB(B1, 0, 1); PG8_STAGE(PG8_SB(0, 0), b2, voffB);
            PG8_BAR; PG8_WAIT_L(0); PG8_MMA(0, 1, At, B1); PG8_BAR;
            PG8_LDA(At, 0, 1); PG8_STAGE(PG8_SA(0, 0), a2, voffA);
            PG8_BAR; PG8_WAIT_L(0); PG8_MMA(1, 0, At, B0); PG8_BAR; PG8_SCHED;
            PG8_STAGE(PG8_SB(0, 1), b2 + hstep, voffB);
            PG8_WAIT_V(6); PG8_BAR; PG8_MMA(1, 1, At, B1); PG8_BAR;
            PG8_LDB(B0, 1, 0); PG8_SCHED; PG8_LDA(At, 1, 0); PG8_STAGE(PG8_SA(0, 1), a2 + hstep, voffA);
            PG8_WAIT_L(8); PG8_BAR; PG8_WAIT_L(0); PG8_MMA(0, 0, At, B0); PG8_BAR; PG8_SCHED;
            PG8_LDB(B1, 1, 1); PG8_STAGE(PG8_SB(1, 0), b3, voffB);
            PG8_BAR; PG8_WAIT_L(0); PG8_MMA(0, 1, At, B1); PG8_BAR;
            PG8_LDA(At, 1, 1); PG8_STAGE(PG8_SA(1, 0), a3, voffA);
            PG8_BAR; PG8_WAIT_L(0); PG8_MMA(1, 0, At, B0); PG8_BAR; PG8_SCHED;
            PG8_STAGE(PG8_SB(1, 1), b3 + hstep, voffB);
            PG8_WAIT_V(6); PG8_BAR; PG8_MMA(1, 1, At, B1); PG8_BAR;
            }
        }
        if constexpr (ALIGN_EPI) { if (wr == 0) PG8_BAR; }
        if constexpr (!Epi::AFTER_DRAIN) { E(acc, cur, wr, wc, fr, fq); S.done(cur); }
        if (!has_next) break;
#pragma unroll
        for (int a = 0; a < 2; ++a)
#pragma unroll
            for (int b = 0; b < 2; ++b)
#pragma unroll
                for (int m = 0; m < 4; ++m)
#pragma unroll
                    for (int n = 0; n < 2; ++n) acc[a][b][m][n] = (f32x4){0.f, 0.f, 0.f, 0.f};
        cur = nxt; cA = nA; cB = nB; ++ui;
        if constexpr (ALIGN_EPI) { if (wr == 1) PG8_BAR; }
    }
    PG8_WAIT_V(0);
    if constexpr (!ALIGN_EPI) { if (wr == 0) PG8_BAR; }
    PG8_BAR;
    if constexpr (Epi::AFTER_DRAIN) { E.fused(acc, cur, wr, wc, fr, fq, lds, wid, lane); S.done(cur); }
#undef PG8_SA
#undef PG8_SB
#undef PG8_STAGE
#undef PG8_LDA
#undef PG8_LDB
#undef PG8_MMA
#undef PG8_WAIT_V
#undef PG8_WAIT_L
#undef PG8_BAR
#undef PG8_SCHED
}
}
namespace pg8 {
struct EpiProjRaw {
    static constexpr bool PERM = true, AFTER_DRAIN = false;
    bf16_t* O; int ldc;
    __device__ __forceinline__ void operator()(const f32x4 (&acc)[2][2][4][2], const Unit& u, int wr, int wc, int fr, int fq) const {
        const int row0 = u.pm * BM + wr * 64 + fr; const int col0 = u.pn * BM + wc * 32 + 8 * fq;
#pragma unroll
        for (int ai = 0; ai < 2; ++ai)
#pragma unroll
            for (int m = 0; m < 4; ++m) { bf16_t* rowp = O + (size_t)(row0 + ai * HALF + m * 16) * ldc + col0;
#pragma unroll
                for (int bj = 0; bj < 2; ++bj) { const f32x4 v0 = acc[ai][bj][m][0], v1 = acc[ai][bj][m][1];
                    u32x4 w; w.x = cvt_pk_bf16(v0[0], v0[1]); w.y = cvt_pk_bf16(v0[2], v0[3]); w.z = cvt_pk_bf16(v1[0], v1[1]); w.w = cvt_pk_bf16(v1[2], v1[3]);
                    *(u32x4*)(rowp + bj * HALF) = w; } }
    }
};
struct EpiOut {
    static constexpr bool PERM = false, AFTER_DRAIN = false;
    const float* X; float* Out; float* SSQ;
    __device__ __forceinline__ void operator()(const f32x4 (&acc)[2][2][4][2], const Unit& u, int wr, int wc, int fr, int fq) const {
        const int col0 = u.pn * BM + wc * 32 + 4 * fq;
#pragma unroll
        for (int ai = 0; ai < 2; ++ai)
#pragma unroll
            for (int m = 0; m < 4; ++m) { const int r = u.pm * BM + ai * HALF + wr * 64 + m * 16 + fr; const size_t off = (size_t)r * 1024 + col0; float ss = 0.f;
#pragma unroll
                for (int bj = 0; bj < 2; ++bj)
#pragma unroll
                    for (int n = 0; n < 2; ++n) { const f32x4 xv = *(const f32x4*)(X + off + bj * HALF + n * 16); const f32x4 o = xv + acc[ai][bj][m][n];
                        *(f32x4*)(Out + off + bj * HALF + n * 16) = o; ss += (o[0] * o[0] + o[1] * o[1]) + (o[2] * o[2] + o[3] * o[3]); }
                ss += __shfl_xor(ss, 16); ss += __shfl_xor(ss, 32);
                if (fq == 0) SSQ[(size_t)r * 16 + u.pn * 4 + wc] = ss; }
    }
};
}
#define GAS __attribute__((address_space(1)))
#define LAS __attribute__((address_space(3)))
typedef unsigned short bf16;
typedef unsigned v4u __attribute__((ext_vector_type(4)));
typedef float f32x4 __attribute__((ext_vector_type(4)));
typedef short bf16x8 __attribute__((ext_vector_type(8)));
typedef GAS unsigned gu32;
typedef GAS unsigned long long gu64;
#define RLX_AGENT __ATOMIC_RELAXED, __HIP_MEMORY_SCOPE_AGENT
#define LDS_WAIT() asm volatile("s_waitcnt lgkmcnt(0)" ::: "memory")
#define VM_WAIT() asm volatile("s_waitcnt vmcnt(0)" ::: "memory")
__device__ __forceinline__ unsigned long long rt() { return __builtin_amdgcn_s_memrealtime(); }
__device__ __forceinline__ unsigned f2bf(float f) { unsigned u = __builtin_bit_cast(unsigned, f); return (u + 0x7fffu + ((u >> 16) & 1u)) >> 16; }
__device__ __forceinline__ unsigned pk2(float lo, float hi) { return f2bf(lo) | (f2bf(hi) << 16); }
#define XB_TMO      128
#define XB_XCNT(j)  (256  + 64 * (j))
#define XB_XSUB(j)  (1280 + 64 * (j))
#define XB_XGEN(j)  (2304 + 64 * (j))
#define XB_TOP      3328
#define XB_TOPGEN   3392
#define XCD_BAR_WORDS 3456
#define XB_SPIN_CAP (1u << 18)

__device__ __forceinline__ unsigned xb_ld(unsigned* p)              { return __hip_atomic_load(p, __ATOMIC_RELAXED, __HIP_MEMORY_SCOPE_AGENT); }
__device__ __forceinline__ unsigned xb_add(unsigned* p, unsigned v) { return __hip_atomic_fetch_add(p, v, __ATOMIC_RELAXED, __HIP_MEMORY_SCOPE_AGENT); }
__device__ __forceinline__ unsigned xb_xcc_id() { return (unsigned)__builtin_amdgcn_s_getreg((3 << 11) | 20) & 0xFu; }
#define XB_SPIN(cond, bar) do { unsigned _sp = 0; while (cond) { __builtin_amdgcn_s_sleep(1); \
    if ((++_sp & 255u) == 0u) { if (xb_ld(&(bar)[XB_TMO])) break; if (_sp > XB_SPIN_CAP) { atomicAdd(&(bar)[XB_TMO], 1u); break; } } } } while (0)

struct XcdBarrier {
    unsigned* bar; unsigned x;
    volatile LAS unsigned* st;
};

__device__ __forceinline__ XcdBarrier xcd_barrier_post(unsigned* bar, volatile LAS unsigned* st) {
    XcdBarrier b; b.bar = bar; b.x = xb_xcc_id(); b.st = st;
    if (threadIdx.x == 0) (void)xb_add(&bar[XB_XCNT(b.x)], 1u);
    return b;
}
__device__ __forceinline__ void xcd_barrier_complete(unsigned* bar, unsigned x, unsigned& nloc, unsigned& nx) {
    const unsigned G = gridDim.x * gridDim.y * gridDim.z;
    unsigned sum, cnt, mine, sp = 0u;
    for (;;) {
        sum = 0u; cnt = 0u; mine = 0u;
#pragma unroll
        for (unsigned j = 0; j < 16; ++j) { const unsigned c = xb_ld(&bar[XB_XCNT(j)]); sum += c; cnt += (c > 0u) ? 1u : 0u; mine = (j == x) ? c : mine; }
        if (sum == G) break;
        __builtin_amdgcn_s_sleep(1);
        if ((++sp & 255u) == 0u) { if (xb_ld(&bar[XB_TMO])) break; if (sp > XB_SPIN_CAP) { atomicAdd(&bar[XB_TMO], 1u); break; } }
    }
    nloc = mine > 0u ? mine : 1u; nx = cnt > 0u ? cnt : 1u;
}

__device__ __forceinline__ void xcd_barrier(const XcdBarrier& b) {
    asm volatile("s_waitcnt vmcnt(0)" ::: "memory");
    __syncthreads();
    if (threadIdx.x == 0) {
        unsigned* bar = b.bar;
        __builtin_amdgcn_s_waitcnt(0);
        unsigned nloc = b.st[0], nx = b.st[1];
        if (nloc == 0u) { xcd_barrier_complete(bar, b.x, nloc, nx); b.st[0] = nloc; b.st[1] = nx; }
        const unsigned old = xb_add(&bar[XB_XSUB(b.x)], 1u);
        const unsigned gen = old / nloc;
        if (old + 1u == (gen + 1u) * nloc) {
            __builtin_amdgcn_fence(__ATOMIC_RELEASE, "agent");
            asm volatile("s_waitcnt vmcnt(0)" ::: "memory");
            const unsigned og = xb_add(&bar[XB_TOP], 1u);
            const unsigned tg = og / nx;
            if (og + 1u == (tg + 1u) * nx) xb_add(&bar[XB_TOPGEN], 1u);
            else XB_SPIN(xb_ld(&bar[XB_TOPGEN]) == tg, bar);
            __builtin_amdgcn_fence(__ATOMIC_ACQUIRE, "agent");
            xb_add(&bar[XB_XGEN(b.x)], 1u);
            asm volatile("s_waitcnt vmcnt(0)" ::: "memory");
        } else {
            XB_SPIN(xb_ld(&bar[XB_XGEN(b.x)]) == gen, bar);
            __builtin_amdgcn_fence(__ATOMIC_ACQUIRE, "agent");
            asm volatile("s_waitcnt vmcnt(0)" ::: "memory");
        }
    }
    __syncthreads();
}
namespace hg {
typedef short s16x4 __attribute__((ext_vector_type(4)));
typedef short h8 __attribute__((ext_vector_type(8)));
typedef float f4 __attribute__((ext_vector_type(4)));
typedef unsigned u4 __attribute__((ext_vector_type(4)));
typedef unsigned u2 __attribute__((ext_vector_type(2)));
#define HG_LAS __attribute__((address_space(3)))
#define HG_GAS __attribute__((address_space(1)))
__device__ __forceinline__ int FSW(int r) { return ((r & 3) << 1) | ((((r >> 2) ^ (r >> 3)) & 1) << 3) | ((r >> 3) & 1); }
__device__ __forceinline__ int toff(int r, int ch) { return r * 256 + ((ch ^ FSW(r & 15)) << 4); }
__device__ __forceinline__ int aoff(int t, int ch) { return t * 128 + ((ch ^ ((t >> 1) & 7)) << 4); }
__device__ __forceinline__ s16x4 vtr(HG_LAS const unsigned char* p) { return __builtin_bit_cast(s16x4, __builtin_amdgcn_ds_read_tr16_b64_v4i16((HG_LAS s16x4*)p)); }
__device__ __forceinline__ unsigned pkbf(float lo, float hi) { typedef float f2_t __attribute__((ext_vector_type(2))); typedef __bf16 b2_t __attribute__((ext_vector_type(2))); f2_t v = {lo, hi}; b2_t b = __builtin_convertvector(v, b2_t); return __builtin_bit_cast(unsigned, b); }
constexpr int OFF_QD = 0, OFF_KI = 16384, OFF_V = 32768, OFF_ATT = 49152, OFF_D = 57344, OFF_OST = 57856, OST_LD = 132;
constexpr int SEQ_ = 4096, NCH = 64;

__device__ __forceinline__ void chain(HG_LAS unsigned char* L, int b, int h, const unsigned short* QD, const unsigned short* KI, const float* DL, const unsigned short* PROJ, unsigned short* MIXED, const float* hgrn_w, float eps) {
    int tid_ = threadIdx.x; asm volatile("" : "+v"(tid_));
    const int tid = tid_, lane = tid & 63, wave = __builtin_amdgcn_readfirstlane(tid >> 6);
    const int l15 = lane & 15, g = lane >> 4, q4 = l15 >> 2, p4 = l15 & 3;
    const int r0 = tid >> 4, ch0 = tid & 15, r1 = r0 + 32;
    const size_t tok0 = (size_t)b * SEQ_;
    const int lo0 = toff(r0, ch0), lo1 = toff(r1, ch0);
    const int et = tid >> 3, ep = tid & 7;
    f4 wv[4];
#pragma unroll
    for (int i = 0; i < 4; ++i) wv[i] = *(const HG_GAS f4*)(hgrn_w + h * 128 + 16 * ep + 4 * i);
    u4 pq0, pq1, pk0, pk1, pv0, pv1; f4 pd = {0.f, 0.f, 0.f, 0.f};
#define HG_LOAD(c) do { const size_t ta = tok0 + (size_t)(c) * 64 + r0, tb = ta + 32; \
        pq0 = *(const HG_GAS u4*)(QD + ta * 512 + h * 128 + ch0 * 8); pq1 = *(const HG_GAS u4*)(QD + tb * 512 + h * 128 + ch0 * 8); \
        pk0 = *(const HG_GAS u4*)(KI + ta * 512 + h * 128 + ch0 * 8); pk1 = *(const HG_GAS u4*)(KI + tb * 512 + h * 128 + ch0 * 8); \
        pv0 = *(const HG_GAS u4*)(PROJ + ta * 4096 + 3072 + h * 128 + ch0 * 8); pv1 = *(const HG_GAS u4*)(PROJ + tb * 4096 + 3072 + h * 128 + ch0 * 8); \
        if (tid < 32) pd = *(const HG_GAS f4*)(DL + ((size_t)b * NCH + (c)) * 512 + h * 128 + tid * 4); } while (0)
#define HG_STORE() do { *(HG_LAS u4*)(L + OFF_QD + lo0) = pq0; *(HG_LAS u4*)(L + OFF_QD + lo1) = pq1; *(HG_LAS u4*)(L + OFF_KI + lo0) = pk0; *(HG_LAS u4*)(L + OFF_KI + lo1) = pk1; \
        *(HG_LAS u4*)(L + OFF_V + lo0) = pv0; *(HG_LAS u4*)(L + OFF_V + lo1) = pv1; if (tid < 32) *(HG_LAS f4*)(L + OFF_D + tid * 16) = pd; } while (0)
    HG_LOAD(0); HG_STORE();
    __syncthreads();
    f4 S[8];
#pragma unroll
    for (int a = 0; a < 8; ++a) S[a] = (f4){0.f, 0.f, 0.f, 0.f};
    for (int c = 0; c < NCH; ++c) {
        if (c + 1 < NCH) HG_LOAD(c + 1);
        const size_t etok = tok0 + (size_t)c * 64 + et;
        const u4 gt0 = *(const HG_GAS u4*)(PROJ + etok * 4096 + 3584 + h * 128 + 16 * ep), gt1 = *(const HG_GAS u4*)(PROJ + etok * 4096 + 3584 + h * 128 + 16 * ep + 8);
        { const int ti = wave >> 1;
#pragma unroll
          for (int sx = 0; sx < 2; ++sx) { const int si = 2 * (wave & 1) + sx; f4 acc = {0.f, 0.f, 0.f, 0.f};
#pragma unroll
              for (int ks = 0; ks < 4; ++ks) { const h8 a = *(const HG_LAS h8*)(L + OFF_KI + toff(16 * si + l15, 4 * ks + g)); const h8 bq = *(const HG_LAS h8*)(L + OFF_QD + toff(16 * ti + l15, 4 * ks + g));
                  acc = __builtin_amdgcn_mfma_f32_16x16x32_bf16(a, bq, acc, 0, 0, 0); }
              const int t = 16 * ti + l15, s0 = 16 * si + 4 * g;
              const float v0 = (s0 + 0 <= t) ? acc[0] : 0.f, v1 = (s0 + 1 <= t) ? acc[1] : 0.f, v2 = (s0 + 2 <= t) ? acc[2] : 0.f, v3 = (s0 + 3 <= t) ? acc[3] : 0.f;
              u2 w; w.x = pkbf(v0, v1); w.y = pkbf(v2, v3);
              *(HG_LAS u2*)(L + OFF_ATT + aoff(t, s0 >> 3) + (s0 & 7) * 2) = w; } }
        h8 vf[2];
#pragma unroll
        for (int ks = 0; ks < 2; ++ks) { const int rr = 32 * ks + 8 * g + q4;
            const s16x4 lo = vtr(L + OFF_V + toff(rr, 2 * wave + (p4 >> 1)) + 8 * (p4 & 1)), hi = vtr(L + OFF_V + toff(rr + 4, 2 * wave + (p4 >> 1)) + 8 * (p4 & 1));
            vf[ks] = (h8){lo[0], lo[1], lo[2], lo[3], hi[0], hi[1], hi[2], hi[3]}; }
        h8 sb[4];
#pragma unroll
        for (int ap = 0; ap < 4; ++ap) { u4 w; w.x = pkbf(S[2 * ap][0], S[2 * ap][1]); w.y = pkbf(S[2 * ap][2], S[2 * ap][3]); w.z = pkbf(S[2 * ap + 1][0], S[2 * ap + 1][1]); w.w = pkbf(S[2 * ap + 1][2], S[2 * ap + 1][3]); sb[ap] = __builtin_bit_cast(h8, w); }
        f4 O[4];
#pragma unroll
        for (int tt = 0; tt < 4; ++tt) { O[tt] = (f4){0.f, 0.f, 0.f, 0.f};
#pragma unroll
            for (int ap = 0; ap < 4; ++ap) { const int row = 16 * tt + l15;
                const u2 x0 = *(const HG_LAS u2*)(L + OFF_QD + toff(row, 4 * ap + (g >> 1)) + 8 * (g & 1)), x1 = *(const HG_LAS u2*)(L + OFF_QD + toff(row, 4 * ap + 2 + (g >> 1)) + 8 * (g & 1));
                u4 w; w.x = x0.x; w.y = x0.y; w.z = x1.x; w.w = x1.y;
                O[tt] = __builtin_amdgcn_mfma_f32_16x16x32_bf16(__builtin_bit_cast(h8, w), sb[ap], O[tt], 0, 0, 0); } }
#pragma unroll
        for (int a = 0; a < 8; ++a) {
#pragma unroll
            for (int ks = 0; ks < 2; ++ks) { const int rr = 32 * ks + 8 * g + q4;
                const s16x4 lo = vtr(L + OFF_KI + toff(rr, 2 * a + (p4 >> 1)) + 8 * (p4 & 1)), hi = vtr(L + OFF_KI + toff(rr + 4, 2 * a + (p4 >> 1)) + 8 * (p4 & 1));
                const h8 kf = (h8){lo[0], lo[1], lo[2], lo[3], hi[0], hi[1], hi[2], hi[3]};
                S[a] = __builtin_amdgcn_mfma_f32_16x16x32_bf16(kf, vf[ks], S[a], 0, 0, 0); }
            const f4 dv = *(const HG_LAS f4*)(L + OFF_D + (16 * a + 4 * g) * 4);
            S[a] = S[a] * dv; }
        __syncthreads();
#pragma unroll
        for (int tt = 0; tt < 4; ++tt)
#pragma unroll
            for (int ks = 0; ks < 2; ++ks) { const h8 a = *(const HG_LAS h8*)(L + OFF_ATT + aoff(16 * tt + l15, 4 * ks + g)); O[tt] = __builtin_amdgcn_mfma_f32_16x16x32_bf16(a, vf[ks], O[tt], 0, 0, 0); }
#pragma unroll
        for (int tt = 0; tt < 4; ++tt)
#pragma unroll
            for (int r = 0; r < 4; ++r) *(HG_LAS float*)(L + OFF_OST + ((16 * tt + 4 * g + r) * OST_LD + 16 * wave + l15) * 4) = O[tt][r];
        __syncthreads();
        { f4 o[4]; float ss = 0.f;
#pragma unroll
          for (int i = 0; i < 4; ++i) { o[i] = *(const HG_LAS f4*)(L + OFF_OST + (et * OST_LD + 16 * ep + 4 * i) * 4); ss += (o[i][0] * o[i][0] + o[i][1] * o[i][1]) + (o[i][2] * o[i][2] + o[i][3] * o[i][3]); }
          ss += __shfl_xor(ss, 1); ss += __shfl_xor(ss, 2); ss += __shfl_xor(ss, 4);
          const float rstd = 1.0f / sqrtf(ss * (1.0f / 128.0f) + eps);
          float y[16];
          const unsigned gw_[8] = {gt0.x, gt0.y, gt0.z, gt0.w, gt1.x, gt1.y, gt1.z, gt1.w};
#pragma unroll
          for (int i = 0; i < 16; ++i) { const float gv = (i & 1) ? __uint_as_float(gw_[i >> 1] & 0xffff0000u) : __uint_as_float(gw_[i >> 1] << 16);
              y[i] = o[i >> 2][i & 3] * rstd * wv[i >> 2][i & 3] * (gv / (1.0f + __expf(-gv))); }
          u4 w0, w1; w0.x = pkbf(y[0], y[1]); w0.y = pkbf(y[2], y[3]); w0.z = pkbf(y[4], y[5]); w0.w = pkbf(y[6], y[7]); w1.x = pkbf(y[8], y[9]); w1.y = pkbf(y[10], y[11]); w1.z = pkbf(y[12], y[13]); w1.w = pkbf(y[14], y[15]);
          *(HG_GAS u4*)(MIXED + etok * 1024 + 512 + h * 128 + 16 * ep) = w0; *(HG_GAS u4*)(MIXED + etok * 1024 + 512 + h * 128 + 16 * ep + 8) = w1; }
        if (c + 1 < NCH) HG_STORE();
        __syncthreads();
    }
#undef HG_LOAD
#undef HG_STORE
}
}
namespace at {
typedef short h8 __attribute__((ext_vector_type(8)));
typedef short s16x4 __attribute__((ext_vector_type(4)));
typedef float f16v __attribute__((ext_vector_type(16)));
typedef unsigned u2 __attribute__((ext_vector_type(2)));
typedef unsigned u4 __attribute__((ext_vector_type(4)));
#define AT_LAS __attribute__((address_space(3)))
#define AT_GAS __attribute__((address_space(1)))
constexpr int SEQ_ = 4096, TT = 32768;
constexpr float C2 = 0.18033688011112042f;
__device__ __forceinline__ int GSW(int row) { const int P = row >> 1; return ((P & 1) << 2) | ((P >> 1) & 3); }
__device__ __forceinline__ s16x4 vtr(AT_LAS const unsigned char* p) { return __builtin_bit_cast(s16x4, __builtin_amdgcn_ds_read_tr16_b64_v4i16((AT_LAS s16x4*)p)); }
__device__ __forceinline__ unsigned pkbf(float lo, float hi) { typedef float f2_t __attribute__((ext_vector_type(2))); typedef __bf16 b2_t __attribute__((ext_vector_type(2))); f2_t v = {lo, hi}; b2_t b = __builtin_convertvector(v, b2_t); return __builtin_bit_cast(unsigned, b); }

__device__ __forceinline__ void unit(AT_LAS unsigned char* Lw, int p, int b, int h, int r, int u, const unsigned short* Q, int qpitch, const unsigned short* K, int kpitch, const unsigned short* V, int vpitch,
                                     unsigned short* PART, float* ML) {
    int lane = threadIdx.x & 63; asm volatile("" : "+v"(lane));
    const int a = lane & 31, hh = lane >> 5, dl = (p == 0) ? 1 : (p == 1) ? 4 : 16;
    const int tokbase = b * SEQ_ + r, i0 = 64 * u;
    h8 qf[2][4];
#pragma unroll
    for (int g = 0; g < 2; ++g)
#pragma unroll
        for (int ks = 0; ks < 4; ++ks) qf[g][ks] = *(const AT_GAS h8*)(Q + (size_t)(tokbase + dl * (i0 + 32 * g + a)) * qpitch + h * 64 + 16 * ks + 8 * hh);
    f16v o[2][2]; float m[2], ls[2];
#pragma unroll
    for (int g = 0; g < 2; ++g) { m[g] = -1e30f; ls[g] = 0.f;
#pragma unroll
        for (int dt = 0; dt < 2; ++dt)
#pragma unroll
            for (int i = 0; i < 16; ++i) o[g][dt][i] = 0.f; }
    const int jlo = (u == 0) ? 4 : (u == 1) ? 2 : 0;
    const int drow = lane >> 3, dcp = lane & 7;
#define AT_DMA(j, bb) do { const int ik0_ = i0 - 128 + 32 * (j); _Pragma("unroll") for (int n_ = 0; n_ < 4; ++n_) { const int row_ = 8 * n_ + drow; const int c_ = dcp ^ GSW(row_); \
        const size_t tok_ = (size_t)(tokbase + dl * (ik0_ + row_)); \
        __builtin_amdgcn_global_load_lds((const unsigned*)(K + tok_ * kpitch + h * 64 + c_ * 8), (AT_LAS unsigned*)(Lw + (bb) * 8192 + n_ * 1024), 16, 0, 0); \
        __builtin_amdgcn_global_load_lds((const unsigned*)(V + tok_ * vpitch + h * 64 + c_ * 8), (AT_LAS unsigned*)(Lw + (bb) * 8192 + 4096 + n_ * 1024), 16, 0, 0); } } while (0)
    asm volatile("" ::: "memory");
    AT_DMA(jlo, 0);
    const int grp = lane >> 4, i15 = lane & 15, q4 = i15 >> 2, p4 = i15 & 3;
    for (int j = jlo; j < 6; ++j) {
        const int bb = (j - jlo) & 1;
        asm volatile("s_waitcnt vmcnt(0)" ::: "memory");
        if (j + 1 < 6) AT_DMA(j + 1, bb ^ 1);
        asm volatile("" ::: "memory");
        AT_LAS const unsigned char* Kt = Lw + bb * 8192; AT_LAS const unsigned char* Vt = Kt + 4096;
#pragma unroll
        for (int g = 0; g < 2; ++g) {
            if ((g == 0 && j <= 4) || (g == 1 && j >= 1)) {
                f16v s;
#pragma unroll
                for (int i = 0; i < 16; ++i) s[i] = 0.f;
#pragma unroll
                for (int ks = 0; ks < 4; ++ks) { const h8 kf = *(const AT_LAS h8*)(Kt + a * 128 + (((2 * ks + hh) ^ GSW(a)) << 4)); s = __builtin_amdgcn_mfma_f32_32x32x16_bf16(kf, qf[g][ks], s, 0, 0, 0); }
                const bool lowb = (j == g), highb = (j == g + 4);
                float mx = -1e30f;
#pragma unroll
                for (int i = 0; i < 16; ++i) { const int kb = (i & 3) + 8 * (i >> 2) + 4 * hh; float x = s[i] * C2; if (lowb && kb < a) x = -1e30f; if (highb && kb > a) x = -1e30f; s[i] = x; mx = fmaxf(mx, x); }
                mx = fmaxf(mx, __shfl_xor(mx, 32));
                const float mn = fmaxf(m[g], mx), alpha = __builtin_amdgcn_exp2f(m[g] - mn); m[g] = mn;
                float rs = 0.f;
#pragma unroll
                for (int i = 0; i < 16; ++i) { s[i] = __builtin_amdgcn_exp2f(s[i] - mn); rs += s[i]; }
                ls[g] = ls[g] * alpha + rs;
#pragma unroll
                for (int dt = 0; dt < 2; ++dt)
#pragma unroll
                    for (int i = 0; i < 16; ++i) o[g][dt][i] *= alpha;
                h8 pb[2];
#pragma unroll
                for (int k2 = 0; k2 < 2; ++k2) { u4 w; w.x = pkbf(s[8 * k2 + 0], s[8 * k2 + 1]); w.y = pkbf(s[8 * k2 + 2], s[8 * k2 + 3]); w.z = pkbf(s[8 * k2 + 4], s[8 * k2 + 5]); w.w = pkbf(s[8 * k2 + 6], s[8 * k2 + 7]); pb[k2] = __builtin_bit_cast(h8, w); }
#pragma unroll
                for (int dt = 0; dt < 2; ++dt)
#pragma unroll
                    for (int k2 = 0; k2 < 2; ++k2) { const int row = 16 * k2 + 4 * hh + q4; const int chk = 4 * dt + 2 * (grp & 1) + (p4 >> 1);
                        const s16x4 lo = vtr(Vt + row * 128 + ((chk ^ GSW(row)) << 4) + 8 * (p4 & 1)), hi = vtr(Vt + (row + 8) * 128 + ((chk ^ GSW(row + 8)) << 4) + 8 * (p4 & 1));
                        const h8 vf = (h8){lo[0], lo[1], lo[2], lo[3], hi[0], hi[1], hi[2], hi[3]};
                        o[g][dt] = __builtin_amdgcn_mfma_f32_32x32x16_bf16(vf, pb[k2], o[g][dt], 0, 0, 0); }
            }
        }
    }
#undef AT_DMA
#pragma unroll
    for (int g = 0; g < 2; ++g) {
        const float lt = ls[g] + __shfl_xor(ls[g], 32); const float inv = 1.0f / lt;
        const size_t rec = ((size_t)p * TT + (size_t)(tokbase + dl * (i0 + 32 * g + a))) * 8 + h;
#pragma unroll
        for (int dt = 0; dt < 2; ++dt)
#pragma unroll
            for (int rq = 0; rq < 4; ++rq) { u2 w; w.x = pkbf(o[g][dt][4 * rq] * inv, o[g][dt][4 * rq + 1] * inv); w.y = pkbf(o[g][dt][4 * rq + 2] * inv, o[g][dt][4 * rq + 3] * inv);
                *(AT_GAS u2*)(PART + rec * 64 + 32 * dt + 8 * rq + 4 * hh) = w; }
        if (hh == 0) { typedef float f2 __attribute__((ext_vector_type(2))); *(AT_GAS f2*)(ML + rec * 2) = (f2){m[g], lt}; }
    }
}
}
constexpr int NWAVES = 8;
constexpr int BATCH = 8, SEQ = 4096, DMODEL = 1024, T = BATCH * SEQ, INC = 4096;
constexpr float NORM_EPS = 1e-6f;
constexpr size_t MiB = 1u << 20;
constexpr size_t WS_CTL = 0, CTL_ZERO_BYTES = 1 * MiB;
constexpr size_t WS_WIN = 2 * MiB, WS_WOUT = 10 * MiB, WS_SSQ = 12 * MiB, WS_DL = 14 * MiB;
constexpr size_t WS_PROJ = 16 * MiB;
constexpr size_t WS_XN = 272 * MiB;
constexpr size_t WS_MIXED = 336 * MiB;
constexpr size_t WS_KI = 272 * MiB, WS_QD = 304 * MiB, WS_PART = 400 * MiB, WS_ML = 496 * MiB, WS_END = 502 * MiB;
constexpr int CW_ATTN_CTR = 64;
constexpr int CW_BAR = 4096;
constexpr int RING_OFF = 0, RING_BYTES = 131072;
constexpr int LDSCTL_OFF = RING_BYTES, MISC_OFF = LDSCTL_OFF + 320;
constexpr int LDS_BYTES = 147456;

__device__ __forceinline__ float bf2f(unsigned short u) { return __uint_as_float(((unsigned)u) << 16); }
__device__ __forceinline__ float sigmoidf_(float x) { return 1.0f / (1.0f + __expf(-x)); }
__device__ __forceinline__ float wave_sum(float v) {
#pragma unroll
    for (int o = 1; o < 64; o <<= 1) v += __shfl_xor(v, o);
    return v;
}
__device__ __forceinline__ float wave_max(float v) {
#pragma unroll
    for (int o = 1; o < 64; o <<= 1) v = fmaxf(v, __shfl_xor(v, o));
    return v;
}
__device__ __forceinline__ float inv_freq(int i) {
    return i == 0 ? 1.0f : i == 1 ? 0.19392274474868576f : i == 2 ? 0.03760603093086393f : i == 3 ? 0.007292664737217109f :
           i == 4 ? 0.001414213562373095f : i == 5 ? 0.0002742481756762073f : i == 6 ? 5.318295896944988e-05f : 1.031338537721246e-05f;
}

struct Args { const float* x; const int* pos; const float* w_in; const float* w_out; const float* mix_w; const float* attn_w; const float* hgrn_w; const float* lb_raw; const float* fin_w; float* out; unsigned char* ws; };

__device__ __forceinline__ void p0_transpose_item(const float* W, int K, int N, bf16* WT, const float* gain, LAS float* scr, int item, int lane) {
    const int nblk = N / 32, kb = item / nblk, nb = item % nblk, k0 = 64 * kb, n0 = 32 * nb;
#pragma unroll 8
    for (int i = 0; i < 32; ++i) { const int kk = 2 * i + (lane >> 5); float w = W[(size_t)(k0 + kk) * N + n0 + (lane & 31)]; if (gain) w *= gain[k0 + kk]; scr[kk * 33 + (lane & 31)] = w; }
    LDS_WAIT(); asm volatile("" ::: "memory");
    const int c = lane & 7;
#pragma unroll
    for (int j = 0; j < 4; ++j) { const int n = (lane >> 3) + 8 * j; const LAS float* s = scr + (8 * c) * 33 + n;
        v4u o; o.x = pk2(s[0 * 33], s[1 * 33]); o.y = pk2(s[2 * 33], s[3 * 33]); o.z = pk2(s[4 * 33], s[5 * 33]); o.w = pk2(s[6 * 33], s[7 * 33]);
        *(GAS v4u*)(WT + (size_t)(n0 + n) * K + k0 + 8 * c) = o; }
    LDS_WAIT(); asm volatile("" ::: "memory");
}

__global__ void __launch_bounds__(NWAVES * 64, 2) fwd_kernel(Args A) {
    extern __shared__ __attribute__((aligned(16))) unsigned char lds[];
    LAS unsigned char* L = (LAS unsigned char*)lds;
    volatile LAS unsigned* MISC = (volatile LAS unsigned*)(L + MISC_OFF);
    const int tid = threadIdx.x, lane = tid & 63, wave = __builtin_amdgcn_readfirstlane(tid >> 6);
    const int G = gridDim.x, bx = blockIdx.x;
    const int vcu = (G % 8 == 0) ? (bx % 8) * (G / 8) + bx / 8 : bx;
    unsigned char* ws = A.ws;
    gu32* ctl = (gu32*)(ws + WS_CTL);
    bf16* WinT = (bf16*)(ws + WS_WIN); bf16* WoT = (bf16*)(ws + WS_WOUT); float* SSQ = (float*)(ws + WS_SSQ);
    bf16* PROJ = (bf16*)(ws + WS_PROJ); bf16* XN = (bf16*)(ws + WS_XN); bf16* KI = (bf16*)(ws + WS_KI); float* DL = (float*)(ws + WS_DL);
    bf16* MIXED = (bf16*)(ws + WS_MIXED); bf16* QD = (bf16*)(ws + WS_QD); bf16* PART = (bf16*)(ws + WS_PART); float* ML = (float*)(ws + WS_ML);
    for (int u = tid; u < (LDS_BYTES - LDSCTL_OFF) / 4; u += NWAVES * 64) ((LAS unsigned*)(L + LDSCTL_OFF))[u] = 0u;
    __syncthreads();
    XcdBarrier bar = xcd_barrier_post((unsigned*)(ctl + CW_BAR), MISC + 8);
    const int gw = vcu * NWAVES + wave, NGW = G * NWAVES;

    {
        LAS float* scr = (LAS float*)(L + RING_OFF + wave * 16384);
        constexpr int I_IN = (DMODEL / 64) * (INC / 32), I_OUT = (DMODEL / 64) * (DMODEL / 32);
        for (int it = gw; it < I_IN + I_OUT; it += NGW) {
            if (it < I_IN) p0_transpose_item(A.w_in, DMODEL, INC, WinT, A.mix_w, scr, it, lane);
            else p0_transpose_item(A.w_out, DMODEL, DMODEL, WoT, nullptr, scr, it - I_IN, lane);
        }
        for (int m = gw; m < T; m += NGW) {
            const GAS f32x4* xr = (const GAS f32x4*)(A.x + (size_t)m * DMODEL) + lane;
            f32x4 v[4]; float s = 0.f;
#pragma unroll
            for (int j = 0; j < 4; ++j) { v[j] = xr[64 * j]; s += (v[j].x * v[j].x + v[j].y * v[j].y) + (v[j].z * v[j].z + v[j].w * v[j].w); }
            const float rstd = 1.f / sqrtf(wave_sum(s) * (1.f / DMODEL) + NORM_EPS);
            GAS unsigned long long* o8 = (GAS unsigned long long*)(XN + (size_t)m * DMODEL) + lane;
#pragma unroll
            for (int j = 0; j < 4; ++j) o8[64 * j] = (unsigned long long)pk2(v[j].x * rstd, v[j].y * rstd) | ((unsigned long long)pk2(v[j].z * rstd, v[j].w * rstd) << 32);
        }
    }
    xcd_barrier(bar);
    {
        pg8::Gemm g{XN, WinT, T, INC, DMODEL}; pg8::StaticOrder S; S.init(T, INC, G, bx);
        pg8::EpiProjRaw E{PROJ, INC};
        pg8::gemm_phase<pg8::EpiProjRaw, pg8::StaticOrder, true, true>(L + RING_OFF, g, S, E);
    }
    xcd_barrier(bar);
    for (int tok = bx; tok < T; tok += G) {
        const int c = tid; bf16* pr = PROJ + (size_t)tok * INC; const int d = c & 63;
        float qv = 0.f, kv = 0.f;
        if (d < 16) {
            qv = bf2f(pr[c]); kv = bf2f(pr[512 + c]);
            const float ang = (float)A.pos[tok] * inv_freq(d & 7); float sn, cs; sincosf(ang, &sn, &cs);
            const int pc = (d < 8) ? c + 8 : c - 8; const float qp = bf2f(pr[pc]), kp = bf2f(pr[512 + pc]);
            if (d < 8) { qv = qv * cs - qp * sn; kv = kv * cs - kp * sn; } else { qv = qv * cs + qp * sn; kv = kv * cs + kp * sn; }
        }
        __syncthreads();
        if (d < 16) { pr[c] = (bf16)f2bf(qv); pr[512 + c] = (bf16)f2bf(kv); }
    }
    for (int cu = bx; cu < BATCH * 64; cu += G) {
        const int c = tid, b = cu >> 6, ch = cu & 63;
        const float lb = 1.0f / (1.0f + expf(A.lb_raw[512 + c] - A.lb_raw[c]));
        float cum = 0.f;
        for (int t = 0; t < 64; ++t) {
            const size_t tok = (size_t)b * SEQ + ch * 64 + t;
            const float hq = bf2f(PROJ[tok * INC + 2048 + c]), hf = bf2f(PROJ[tok * INC + 2560 + c]);
            const float sg = 1.0f / (1.0f + expf(-hf)); const float f = lb + (1.0f - lb) * sg;
            cum += logf(f); const float e = expf(cum);
            QD[tok * 512 + c] = (bf16)f2bf(hq / (1.0f + expf(-hq)) * e); KI[tok * 512 + c] = (bf16)f2bf((1.0f - lb) * (1.0f - sg) / e);
        }
        DL[(size_t)cu * 512 + c] = expf(cum);
    }
    xcd_barrier(bar);
    if (bx < 32) hg::chain(L + RING_OFF, bx >> 2, bx & 3, QD, KI, DL, PROJ, MIXED, A.hgrn_w, NORM_EPS);
    {
        LAS unsigned char* Lw = L + RING_OFF + wave * 16384;
        for (;;) {
            int id = 0; if (lane == 0) id = (int)__hip_atomic_fetch_add((unsigned*)(ctl + CW_ATTN_CTR), 1u, __ATOMIC_RELAXED, __HIP_MEMORY_SCOPE_AGENT);
            id = __builtin_amdgcn_readfirstlane(id);
            if (id >= 64 * 192) break;
            const int bh = id / 192, rem = id % 192, p = rem >> 6, w = rem & 63;
            const int dl = (p == 0) ? 1 : (p == 1) ? 4 : 16; const int nu = 64 / dl;
            const int r = w / nu, u = w % nu;
            at::unit(Lw, p, bh >> 3, bh & 7, r, u, PROJ, INC, PROJ + 512, INC, PROJ + 1024, INC, PART, ML);
        }
    }
    xcd_barrier(bar);
    for (int tok = gw; tok < T; tok += NGW) {
        const int h = lane >> 3, dc = lane & 7;
        float mm[3], ll[3]; v4u ov[3];
#pragma unroll
        for (int p = 0; p < 3; ++p) { const size_t rec = ((size_t)p * T + tok) * 8 + h; typedef float f2 __attribute__((ext_vector_type(2))); const f2 ml = *(const GAS f2*)(ML + rec * 2); mm[p] = ml.x; ll[p] = ml.y;
            ov[p] = *(const GAS v4u*)(PART + rec * 64 + 8 * dc); }
        const float M = fmaxf(fmaxf(mm[0], mm[1]), mm[2]);
        float wgt[3]; float den = 0.f;
#pragma unroll
        for (int p = 0; p < 3; ++p) { wgt[p] = __builtin_amdgcn_exp2f(mm[p] - M) * ll[p]; den += wgt[p]; }
        const float rden = 1.0f / den;
        float at_[8]; float ss = 0.f;
#pragma unroll
        for (int i = 0; i < 8; ++i) { float acc = 0.f;
#pragma unroll
            for (int p = 0; p < 3; ++p) { const unsigned wd = (i >> 1) == 0 ? ov[p].x : (i >> 1) == 1 ? ov[p].y : (i >> 1) == 2 ? ov[p].z : ov[p].w; const float v = (i & 1) ? __uint_as_float(wd & 0xffff0000u) : __uint_as_float(wd << 16); acc += wgt[p] * v; }
            at_[i] = acc * rden; ss += at_[i] * at_[i]; }
        ss += __shfl_xor(ss, 1); ss += __shfl_xor(ss, 2); ss += __shfl_xor(ss, 4);
        const float rstd = 1.0f / sqrtf(ss * (1.0f / 64.0f) + NORM_EPS);
        const v4u gt = *(const GAS v4u*)(PROJ + (size_t)tok * INC + 1536 + h * 64 + 8 * dc);
        const f32x4 w0 = *(const GAS f32x4*)(A.attn_w + h * 64 + 8 * dc), w1 = *(const GAS f32x4*)(A.attn_w + h * 64 + 8 * dc + 4);
        float y[8];
#pragma unroll
        for (int i = 0; i < 8; ++i) { const unsigned wd = (i >> 1) == 0 ? gt.x : (i >> 1) == 1 ? gt.y : (i >> 1) == 2 ? gt.z : gt.w; const float gv = (i & 1) ? __uint_as_float(wd & 0xffff0000u) : __uint_as_float(wd << 16);
            y[i] = at_[i] * rstd * (i < 4 ? w0[i & 3] : w1[i & 3]) * (gv / (1.0f + __expf(-gv))); }
        v4u o; o.x = pk2(y[0], y[1]); o.y = pk2(y[2], y[3]); o.z = pk2(y[4], y[5]); o.w = pk2(y[6], y[7]);
        *(GAS v4u*)(MIXED + (size_t)tok * DMODEL + h * 64 + 8 * dc) = o;
    }
    xcd_barrier(bar);
    {
        pg8::Gemm g{MIXED, WoT, T, DMODEL, DMODEL}; pg8::StaticOrder S; S.init(T, DMODEL, G, bx);
        pg8::EpiOut E{A.x, A.out, SSQ};
        pg8::gemm_phase<pg8::EpiOut, pg8::StaticOrder, true, true>(L + RING_OFF, g, S, E);
    }
    xcd_barrier(bar);
    for (int m = gw; m < T; m += NGW) {
        float s = (lane < 16) ? SSQ[(size_t)m * 16 + lane] : 0.f; s = wave_sum(s);
        const float rstd = 1.f / sqrtf(s * (1.f / DMODEL) + NORM_EPS);
        GAS f32x4* xr = (GAS f32x4*)(A.out + (size_t)m * DMODEL) + lane; const GAS f32x4* wr_ = (const GAS f32x4*)A.fin_w + lane;
#pragma unroll
        for (int j = 0; j < 4; ++j) { f32x4 v = xr[64 * j]; const f32x4 w = wr_[64 * j]; v = v * rstd * w; xr[64 * j] = v; }
    }
}

extern "C" void kernel_launch(void* const* d_in, const int* in_sizes, int n_in, void* d_out, int out_size, void* d_ws, size_t ws_size, hipStream_t stream) {
    static int grid = 0;
    if (grid == 0) {
        if (n_in != 9 || in_sizes[0] != T * DMODEL || out_size != T * DMODEL || ws_size < WS_END) { fprintf(stderr, "kernel_launch: unexpected shapes/ws (n_in %d, ws %zu)\n", n_in, ws_size); grid = -1; return; }
        int dev = 0, cus = 0, per_cu = 0;
        if (hipGetDevice(&dev) != hipSuccess || hipDeviceGetAttribute(&cus, hipDeviceAttributeMultiprocessorCount, dev) != hipSuccess) { grid = -1; return; }
        if (hipFuncSetAttribute((const void*)fwd_kernel, hipFuncAttributeMaxDynamicSharedMemorySize, LDS_BYTES) != hipSuccess) { fprintf(stderr, "kernel_launch: hipFuncSetAttribute failed\n"); grid = -1; return; }
        if (hipOccupancyMaxActiveBlocksPerMultiprocessor(&per_cu, (const void*)fwd_kernel, NWAVES * 64, LDS_BYTES) != hipSuccess || per_cu < 1) { fprintf(stderr, "kernel_launch: occupancy query says %d blocks/CU\n", per_cu); grid = -1; (void)hipGetLastError(); return; }
        grid = cus;
    }
    if (grid < 0) return;
    (void)hipMemsetAsync((char*)d_ws + WS_CTL, 0, CTL_ZERO_BYTES, stream);
    Args a{};
    a.x = (const float*)d_in[0]; a.pos = (const int*)d_in[1]; a.w_in = (const float*)d_in[2]; a.w_out = (const float*)d_in[3]; a.mix_w = (const float*)d_in[4];
    a.attn_w = (const float*)d_in[5]; a.hgrn_w = (const float*)d_in[6]; a.lb_raw = (const float*)d_in[7]; a.fin_w = (const float*)d_in[8];
    a.out = (float*)d_out; a.ws = (unsigned char*)d_ws;
    hipLaunchKernelGGL(fwd_kernel, dim3(grid), dim3(NWAVES * 64), LDS_BYTES, stream, a);
}
```

```cpp
#include <hip/hip_runtime.h>
#include <cstdio>
#include <cstdint>
namespace pg8 {
#define PG8_LAS __attribute__((address_space(3)))
typedef unsigned short bf16_t;
typedef short bf16x8 __attribute__((ext_vector_type(8)));
typedef float f32x4 __attribute__((ext_vector_type(4)));
typedef unsigned u32x4 __attribute__((ext_vector_type(4)));
constexpr int BM = 256, BK = 64, HALF = 128, HTB = HALF * BK * 2  , STAGE_BYTES = 8 * HTB, NXCD = 8, WGM = 8;

__host__ __device__ __forceinline__ int lds_byte(int r, int c) { const int st = (r >> 4) * 2 + (c >> 5), rr = r & 15, cc = c & 31, ob = rr * 64 + cc * 2; return st * 1024 + (ob ^ (((ob >> 9) & 1) << 5)); }
__host__ __device__ __forceinline__ void stage_rc(int b, int& R, int& C) { const int st = b / 1024, sb = b % 1024, swz = sb ^ (((sb >> 9) & 1) << 5); R = (st >> 1) * 16 + swz / 64; C = (st & 1) * 32 + (swz % 64) / 2; }
__host__ __device__ __forceinline__ int perm32(int rho) { const int n = rho >> 4, i = rho & 15; return 8 * (i >> 2) + 4 * n + (i & 3); }

struct Unit { int pm, pn; };
struct Gemm { const bf16_t* A; const bf16_t* Bt; int M, N, K; };

struct StaticOrder {
    int nM, nN, nwg, G, c;
    __host__ __device__ void init(int M, int N, int G_, int c_) { nM = M / BM; nN = N / BM; nwg = nM * nN; G = G_; c = c_; }
    __host__ __device__ bool next(int i, Unit& u) const {
        const long L = (long)i * G + c; if (L >= nwg) return false;
        int wgid = (int)L; { const int q = nwg / NXCD, r = nwg % NXCD, xcd = wgid % NXCD, off = wgid / NXCD; wgid = (xcd < r ? xcd * (q + 1) : r * (q + 1) + (xcd - r) * q) + off; }
        const int nig = WGM * nN, gid = wgid / nig, fm = gid * WGM, gsz = (nM - fm) < WGM ? (nM - fm) : WGM;
        u.pm = fm + ((wgid % nig) % gsz); u.pn = (wgid % nig) / gsz; return true;
    }
    __device__ __forceinline__ void a_ready(const Unit&) const {}
    __device__ __forceinline__ void done(const Unit&) const {}
};

__device__ __forceinline__ unsigned cvt_pk_bf16(float lo, float hi) { unsigned r; asm volatile("v_cvt_pk_bf16_f32 %0, %1, %2" : "=v"(r) : "v"(lo), "v"(hi)); return r; }
typedef float f32x2 __attribute__((ext_vector_type(2)));
template <class Epi, class Sched, bool ALIGN_EPI = false, bool SP2 = false>
__device__ __forceinline__ void gemm_phase(PG8_LAS unsigned char* lds, const Gemm g, const Sched& S, const Epi& E) {
    int tid_ = threadIdx.x; asm volatile("" : "+v"(tid_));
    const int tid = tid_, wid = __builtin_amdgcn_readfirstlane(tid >> 6), lane = tid & 63, wr = wid >> 2, wc = wid & 3, fr = lane & 15, fq = lane >> 4;
    const int K = g.K, nt = K / BK;
    unsigned voffA[2], voffB[2];
#pragma unroll
    for (int i = 0; i < 2; ++i) { int R, C; stage_rc(tid * 16 + i * 8192, R, C); const int Rb = Epi::PERM ? ((R & ~31) + perm32(R & 31)) : R;
        voffA[i] = (unsigned)(R * K + C) * 2u; voffB[i] = (unsigned)(Rb * K + C) * 2u; }
    const size_t kstep = (size_t)(BK * 2);
    const size_t hstep = (size_t)HALF * K * 2;
    const size_t tstep = 2 * hstep;
    const unsigned ldsw = (unsigned)wid * 1024u;
    const int aoff = lds_byte(wr * 64 + fr, fq * 8), boff = lds_byte(wc * 32 + fr, fq * 8);
#define PG8_SA(b, h) (((b) * 2 + (h)) * HTB)
#define PG8_SB(b, h) ((4 + (b) * 2 + (h)) * HTB)
#define PG8_STAGE(bufoff, gbase, voff) do { _Pragma("unroll") for (int _i = 0; _i < 2; ++_i) \
        __builtin_amdgcn_global_load_lds((const unsigned*)((const char*)(gbase) + (voff)[_i]), (PG8_LAS unsigned*)(lds + (bufoff) + ldsw + _i * 8192), 16, 0, 0); } while (0)
#define PG8_LDA(dst, b, h) do { _Pragma("unroll") for (int m = 0; m < 4; ++m) _Pragma("unroll") for (int k = 0; k < 2; ++k) dst[m][k] = *(const PG8_LAS bf16x8*)(lds + PG8_SA(b, h) + aoff + m * 2048 + k * 1024); } while (0)
#define PG8_LDB(dst, b, h) do { _Pragma("unroll") for (int n = 0; n < 2; ++n) _Pragma("unroll") for (int k = 0; k < 2; ++k) dst[n][k] = *(const PG8_LAS bf16x8*)(lds + PG8_SB(b, h) + boff + n * 2048 + k * 1024); } while (0)
#define PG8_MMA(ai, bj, At, Bt) do { __builtin_amdgcn_s_setprio(1); _Pragma("unroll") for (int m = 0; m < 4; ++m) _Pragma("unroll") for (int n = 0; n < 2; ++n) _Pragma("unroll") for (int k = 0; k < 2; ++k) \
        acc[ai][bj][m][n] = __builtin_amdgcn_mfma_f32_16x16x32_bf16(Bt[n][k], At[m][k], acc[ai][bj][m][n], 0, 0, 0); __builtin_amdgcn_s_setprio(0); } while (0)
#define PG8_WAIT_V(n) asm volatile("s_waitcnt vmcnt(" #n ")" ::: "memory")
#define PG8_WAIT_L(n) asm volatile("s_waitcnt lgkmcnt(" #n ")" ::: "memory")
#define PG8_BAR __builtin_amdgcn_s_barrier()
#define PG8_SCHED __builtin_amdgcn_sched_barrier(0)
    Unit cur, nxt; int ui = 0;
    if (!S.next(0, cur)) return;
    f32x4 acc[2][2][4][2];
#pragma unroll
    for (int a = 0; a < 2; ++a)
#pragma unroll
        for (int b = 0; b < 2; ++b)
#pragma unroll
            for (int m = 0; m < 4; ++m)
#pragma unroll
                for (int n = 0; n < 2; ++n) acc[a][b][m][n] = (f32x4){0.f, 0.f, 0.f, 0.f};
    bf16x8 At[4][2], B0[2][2], B1[2][2];
    const char* cA = (const char*)g.A + (size_t)cur.pm * tstep; const char* cB = (const char*)g.Bt + (size_t)cur.pn * tstep;
    S.a_ready(cur);
    if constexpr (SP2) {
        PG8_STAGE(PG8_SB(0, 0), cB, voffB); PG8_STAGE(PG8_SB(0, 1), cB + hstep, voffB); PG8_STAGE(PG8_SA(0, 0), cA, voffA); PG8_STAGE(PG8_SA(0, 1), cA + hstep, voffA);
        if (wr == 1) PG8_BAR;
        PG8_WAIT_V(2); PG8_BAR;
        PG8_STAGE(PG8_SB(1, 0), cB + kstep, voffB); PG8_STAGE(PG8_SA(1, 0), cA + kstep, voffA); PG8_STAGE(PG8_SB(1, 1), cB + hstep + kstep, voffB);
        PG8_WAIT_V(6); PG8_BAR;
    } else {
        PG8_STAGE(PG8_SB(0, 0), cB, voffB); PG8_STAGE(PG8_SA(0, 0), cA, voffA); PG8_STAGE(PG8_SB(0, 1), cB + hstep, voffB); PG8_STAGE(PG8_SA(0, 1), cA + hstep, voffA);
        if (wr == 1) PG8_BAR;
        PG8_WAIT_V(4); PG8_BAR;
        PG8_STAGE(PG8_SB(1, 0), cB + kstep, voffB); PG8_STAGE(PG8_SA(1, 0), cA + kstep, voffA); PG8_STAGE(PG8_SB(1, 1), cB + hstep + kstep, voffB);
        PG8_WAIT_V(6); PG8_BAR;
    }
    for (;;) {
        const bool has_next = S.next(ui + 1, nxt);
        const char* nA = has_next ? (const char*)g.A + (size_t)nxt.pm * tstep : cA; const char* nB = has_next ? (const char*)g.Bt + (size_t)nxt.pn * tstep : cB;
        for (int t = 0; t < nt; t += 2) {
            const bool last = (t == nt - 2);
            const char* a1 = cA + (size_t)(t + 1) * kstep;
            const char* a2 = last ? nA : cA + (size_t)(t + 2) * kstep; const char* b2 = last ? nB : cB + (size_t)(t + 2) * kstep;
            const char* a3 = a2 + kstep; const char* b3 = b2 + kstep;
            if (last && has_next) S.a_ready(nxt);
            if constexpr (SP2) {
            PG8_LDB(B0, 0, 0); PG8_LDB(B1, 0, 1); PG8_SCHED; PG8_LDA(At, 0, 0); PG8_STAGE(PG8_SA(1, 1), a1 + hstep, voffA);
            PG8_WAIT_V(8); PG8_WAIT_L(0); PG8_BAR; PG8_MMA(0, 0, At, B0); PG8_MMA(0, 1, At, B1); PG8_BAR; PG8_SCHED;
            PG8_LDA(At, 0, 1); PG8_STAGE(PG8_SB(0, 0), b2, voffB); PG8_STAGE(PG8_SB(0, 1), b2 + hstep, voffB); PG8_STAGE(PG8_SA(0, 0), a2, voffA);
            PG8_WAIT_V(8); PG8_WAIT_L(0); PG8_BAR; PG8_MMA(1, 0, At, B0); PG8_MMA(1, 1, At, B1); PG8_BAR; PG8_SCHED;
            PG8_LDB(B0, 1, 0); PG8_LDB(B1, 1, 1); PG8_SCHED; PG8_LDA(At, 1, 0); PG8_STAGE(PG8_SA(0, 1), a2 + hstep, voffA);
            PG8_WAIT_V(8); PG8_WAIT_L(0); PG8_BAR; PG8_MMA(0, 0, At, B0); PG8_MMA(0, 1, At, B1); PG8_BAR; PG8_SCHED;
            PG8_LDA(At, 1, 1); PG8_STAGE(PG8_SB(1, 0), b3, voffB); PG8_STAGE(PG8_SB(1, 1), b3 + hstep, voffB); PG8_STAGE(PG8_SA(1, 0), a3, voffA);
            PG8_WAIT_V(8); PG8_WAIT_L(0); PG8_BAR; PG8_MMA(1, 0, At, B0); PG8_MMA(1, 1, At, B1); PG8_BAR; PG8_SCHED;
            } else {
            PG8_LDB(B0, 0, 0); PG8_SCHED; PG8_LDA(At, 0, 0); PG8_STAGE(PG8_SA(1, 1), a1 + hstep, voffA);
            PG8_WAIT_L(8); PG8_BAR; PG8_WAIT_L(0); PG8_MMA(0, 0, At, B0); PG8_BAR; PG8_SCHED;
            PG8_LDB(B1, 0, 1); PG8_STAGE(PG8_SB(0, 0), b2, voffB);
            PG8_BAR; PG8_WAIT_L(0); PG8_MMA(0, 1, At, B1); PG8_BAR;
            PG8_LDA(At, 0, 1); PG8_STAGE(PG8_SA(0, 0), a2, voffA);
            PG8_BAR; PG8_WAIT_L(0); PG8_MMA(1, 0, At, B0); PG8_BAR; PG8_SCHED;
            PG8_STAGE(PG8_SB(0, 1), b2 + hstep, voffB);
            PG8_WAIT_V(6); PG8_BAR; PG8_MMA(1, 1, At, B1); PG8_BAR;
            PG8_LDB(B0, 1, 0); PG8_SCHED; PG8_LDA(At, 1, 0); PG8_STAGE(PG8_SA(0, 1), a2 + hstep, voffA);
            PG8_WAIT_L(8); PG8_BAR; PG8_WAIT_L(0); PG8_MMA(0, 0, At, B0); PG8_BAR; PG8_SCHED;
            PG8_LDB(B1, 1, 1); PG8_STAGE(PG8_SB(1, 0), b3, voffB);
            PG8_BAR; PG8_WAIT_L(0); PG8_MMA(0, 1, At, B1); PG8_BAR;
            PG8_LDA(At, 1, 1); PG8_STAGE(PG8_SA(1, 0), a3, voffA);
            PG8_BAR; PG8_WAIT_L(0); PG8_MMA(1, 0, At, B0); PG8_BAR; PG8_SCHED;
            PG8_STAGE(PG8_SB(1, 1), b3 + hstep, voffB);
            PG8_WAIT_V(6); PG8_BAR; PG8_MMA(1, 1, At, B1); PG8_BAR;
            }
        }
        if constexpr (ALIGN_EPI) { if (wr == 0) PG8_BAR; }
        if constexpr (!Epi::AFTER_DRAIN) { E(acc, cur, wr, wc, fr, fq); S.done(cur); }
        if (!has_next) break;
#pragma unroll
        for (int a = 0; a < 2; ++a)
#pragma unroll
            for (int b = 0; b < 2; ++b)
#pragma unroll
                for (int m = 0; m < 4; ++m)
#pragma unroll
                    for (int n = 0; n < 2; ++n) acc[a][b][m][n] = (f32x4){0.f, 0.f, 0.f, 0.f};
        cur = nxt; cA = nA; cB = nB; ++ui;
        if constexpr (ALIGN_EPI) { if (wr == 1) PG8_BAR; }
    }
    PG8_WAIT_V(0);
    if constexpr (!ALIGN_EPI) { if (wr == 0) PG8_BAR; }
    PG8_BAR;
    if constexpr (Epi::AFTER_DRAIN) { E.fused(acc, cur, wr, wc, fr, fq, lds, wid, lane); S.done(cur); }
#undef PG8_SA
#undef PG8_SB
#undef PG8_STAGE
#undef PG8_LDA
#undef PG8_LDB
#undef PG8_MMA
#undef PG8_WAIT_V
#undef PG8_WAIT_L
#undef PG8_BAR
#undef PG8_SCHED
}
}
namespace pg8 {
struct EpiProjRaw {
    static constexpr bool PERM = true, AFTER_DRAIN = false;
    bf16_t* O; int ldc;
    __device__ __forceinline__ void operator()(const f32x4 (&acc)[2][2][4][2], const Unit& u, int wr, int wc, int fr, int fq) const {
        const int row0 = u.pm * BM + wr * 64 + fr; const int col0 = u.pn * BM + wc * 32 + 8 * fq;
#pragma unroll
        for (int ai = 0; ai < 2; ++ai)
#pragma unroll
            for (int m = 0; m < 4; ++m) { bf16_t* rowp = O + (size_t)(row0 + ai * HALF + m * 16) * ldc + col0;
#pragma unroll
                for (int bj = 0; bj < 2; ++bj) { const f32x4 v0 = acc[ai][bj][m][0], v1 = acc[ai][bj][m][1];
                    u32x4 w; w.x = cvt_pk_bf16(v0[0], v0[1]); w.y = cvt_pk_bf16(v0[2], v0[3]); w.z = cvt_pk_bf16(v1[0], v1[1]); w.w = cvt_pk_bf16(v1[2], v1[3]);
                    *(u32x4*)(rowp + bj * HALF) = w; } }
    }
};
struct EpiOut {
    static constexpr bool PERM = false, AFTER_DRAIN = false;
    const float* X; float* Out; float* SSQ;
    __device__ __forceinline__ void operator()(const f32x4 (&acc)[2][2][4][2], const Unit& u, int wr, int wc, int fr, int fq) const {
        const int col0 = u.pn * BM + wc * 32 + 4 * fq;
#pragma unroll
        for (int ai = 0; ai < 2; ++ai)
#pragma unroll
            for (int m = 0; m < 4; ++m) { const int r = u.pm * BM + ai * HALF + wr * 64 + m * 16 + fr; const size_t off = (size_t)r * 1024 + col0; float ss = 0.f;
#pragma unroll
                for (int bj = 0; bj < 2; ++bj)
#pragma unroll
                    for (int n = 0; n < 2; ++n) { const f32x4 xv = *(const f32x4*)(X + off + bj * HALF + n * 16); const f32x4 o = xv + acc[ai][bj][m][n];
                        *(f32x4*)(Out + off + bj * HALF + n * 16) = o; ss += (o[0] * o[0] + o[1] * o[1]) + (o[2] * o[2] + o[3] * o[3]); }
                ss += __shfl_xor(ss, 16); ss += __shfl_xor(ss, 32);
                if (fq == 0) SSQ[(size_t)r * 16 + u.pn * 4 + wc] = ss; }
    }
};
}
namespace pg8 {
struct EpiProj {
    static constexpr bool PERM = true, AFTER_DRAIN = false;
    bf16_t* B8;     float* DL; const float* CS; const float* lb_raw; float qscale;
    __device__ __forceinline__ static void st8(bf16_t* p, const f32x4& v0, const f32x4& v1) { u32x4 w; w.x = cvt_pk_bf16(v0[0], v0[1]); w.y = cvt_pk_bf16(v0[2], v0[3]); w.z = cvt_pk_bf16(v1[0], v1[1]); w.w = cvt_pk_bf16(v1[2], v1[3]); *(u32x4*)p = w; }
    __device__ __forceinline__ static void st4(bf16_t* p, const f32x4& v0) { typedef unsigned u32x2 __attribute__((ext_vector_type(2))); u32x2 w; w.x = cvt_pk_bf16(v0[0], v0[1]); w.y = cvt_pk_bf16(v0[2], v0[3]); *(u32x2*)p = w; }
    __device__ __forceinline__ static f32x4 silu4(const f32x4& x) { f32x4 r; r[0] = x[0] / (1.0f + __expf(-x[0])); r[1] = x[1] / (1.0f + __expf(-x[1])); r[2] = x[2] / (1.0f + __expf(-x[2])); r[3] = x[3] / (1.0f + __expf(-x[3])); return r; }
    __device__ __forceinline__ void operator()(const f32x4 (&acc)[2][2][4][2], const Unit& u, int wr, int wc, int fr, int fq) const {
        constexpr size_t TS = (size_t)32768 * 512; bf16_t* const QD = B8 + 4 * TS; bf16_t* const KI = B8 + 5 * TS;
        const int pn = u.pn; const int row0 = u.pm * BM + wr * 64 + fr; const int cw = wc * 32 + 8 * fq;
        if (pn < 4) {
            bf16_t* base = B8 + (size_t)(pn >> 1) * TS; const float sc = (pn < 2) ? qscale : 1.0f; const int colt = (pn & 1) * 256;
            const bool rot = ((wc & 1) == 0) && (fq < 2);
#pragma unroll
            for (int ai = 0; ai < 2; ++ai)
#pragma unroll
                for (int m = 0; m < 4; ++m) { const int row = row0 + ai * HALF + m * 16;
                    f32x4 cs4 = {1.f, 1.f, 1.f, 1.f}, sn4 = {0.f, 0.f, 0.f, 0.f};
                    if (rot) { cs4 = *(const f32x4*)(CS + (size_t)row * 16 + 4 * fq); sn4 = *(const f32x4*)(CS + (size_t)row * 16 + 8 + 4 * fq); }
#pragma unroll
                    for (int bj = 0; bj < 2; ++bj) { const int col = colt + bj * HALF + cw; const f32x4 v0 = acc[ai][bj][m][0] * sc, v1 = acc[ai][bj][m][1] * sc;
                        bf16_t* rp = base + (size_t)row * 512 + col;
                        if (rot) { const f32x4 o1 = v0 * cs4 - v1 * sn4, o2 = v1 * cs4 + v0 * sn4; st4(rp - 4 * fq, o1); st4(rp - 4 * fq + 8, o2); }
                        else st8(rp, v0, v1); } }
        } else if (pn >= 8 && pn < 12) {
            const int h = pn - 8; float lbv[8], omlb[8];
#pragma unroll
            for (int k = 0; k < 8; ++k) { const int c = 128 * h + cw + k; lbv[k] = 1.0f / (1.0f + __expf(lb_raw[512 + c] - lb_raw[c])); omlb[k] = 1.0f - lbv[k]; }
#pragma unroll
            for (int ai = 0; ai < 2; ++ai) {
                float run[8];
#pragma unroll
                for (int k = 0; k < 8; ++k) run[k] = 0.f;
#pragma unroll
                for (int m = 0; m < 4; ++m) { const int row = row0 + ai * HALF + m * 16; f32x4 qd[2], ki[2];
#pragma unroll
                    for (int k = 0; k < 8; ++k) { const int n = k >> 2, j = k & 3;
                        const float hf = acc[ai][1][m][n][j], hq = acc[ai][0][m][n][j];
                        const float sg = 1.0f / (1.0f + __expf(-hf)); const float f = lbv[k] + omlb[k] * sg;
                        float v = __builtin_amdgcn_logf(f);
                        float t;
                        t = __shfl_up(v, 1, 16); if (fr >= 1) v += t;
                        t = __shfl_up(v, 2, 16); if (fr >= 2) v += t;
                        t = __shfl_up(v, 4, 16); if (fr >= 4) v += t;
                        t = __shfl_up(v, 8, 16); if (fr >= 8) v += t;
                        v += run[k]; run[k] = __shfl(v, 15, 16);
                        const float e = __builtin_amdgcn_exp2f(v), ie = __builtin_amdgcn_exp2f(-v);
                        qd[n][j] = hq / (1.0f + __expf(-hq)) * e; ki[n][j] = omlb[k] * (1.0f - sg) * ie; }
                    st8(QD + (size_t)row * 512 + 128 * h + cw, qd[0], qd[1]); st8(KI + (size_t)row * 512 + 128 * h + cw, ki[0], ki[1]); }
                if (fr == 15) { const int chunk = (u.pm * BM + ai * HALF + wr * 64) >> 6; float* dp = DL + (size_t)chunk * 512 + 128 * h + cw;
                    f32x4 d0, d1;
#pragma unroll
                    for (int j = 0; j < 4; ++j) { d0[j] = __builtin_amdgcn_exp2f(run[j]); d1[j] = __builtin_amdgcn_exp2f(run[4 + j]); }
                    *(f32x4*)dp = d0; *(f32x4*)(dp + 4) = d1; } }
        } else {
            bf16_t* base; int colt; bool act;
            base = B8 + (size_t)(pn >> 1) * TS; colt = (pn & 1) * 256; act = ((pn >> 1) & 1) != 0;
#pragma unroll
            for (int ai = 0; ai < 2; ++ai)
#pragma unroll
                for (int m = 0; m < 4; ++m) { const int row = row0 + ai * HALF + m * 16;
#pragma unroll
                    for (int bj = 0; bj < 2; ++bj) { f32x4 v0 = acc[ai][bj][m][0], v1 = acc[ai][bj][m][1]; if (act) { v0 = silu4(v0); v1 = silu4(v1); }
                        st8(base + (size_t)row * 512 + colt + bj * HALF + cw, v0, v1); } }
        }
    }
};
}
#define GAS __attribute__((address_space(1)))
#define LAS __attribute__((address_space(3)))
typedef unsigned short bf16;
typedef unsigned v4u __attribute__((ext_vector_type(4)));
typedef float f32x4 __attribute__((ext_vector_type(4)));
typedef short bf16x8 __attribute__((ext_vector_type(8)));
typedef GAS unsigned gu32;
typedef GAS unsigned long long gu64;
#define RLX_AGENT __ATOMIC_RELAXED, __HIP_MEMORY_SCOPE_AGENT
#define LDS_WAIT() asm volatile("s_waitcnt lgkmcnt(0)" ::: "memory")
#define VM_WAIT() asm volatile("s_waitcnt vmcnt(0)" ::: "memory")
__device__ __forceinline__ unsigned long long rt() { return __builtin_amdgcn_s_memrealtime(); }
__device__ __forceinline__ unsigned f2bf(float f) { unsigned u = __builtin_bit_cast(unsigned, f); return (u + 0x7fffu + ((u >> 16) & 1u)) >> 16; }
__device__ __forceinline__ unsigned pk2(float lo, float hi) { return f2bf(lo) | (f2bf(hi) << 16); }
#define XB_TMO      128
#define XB_XCNT(j)  (256  + 64 * (j))
#define XB_XSUB(j)  (1280 + 64 * (j))
#define XB_XGEN(j)  (2304 + 64 * (j))
#define XB_TOP      3328
#define XB_TOPGEN   3392
#define XCD_BAR_WORDS 3456
#define XB_SPIN_CAP (1u << 18)

__device__ __forceinline__ unsigned xb_ld(unsigned* p)              { return __hip_atomic_load(p, __ATOMIC_RELAXED, __HIP_MEMORY_SCOPE_AGENT); }
__device__ __forceinline__ unsigned xb_add(unsigned* p, unsigned v) { return __hip_atomic_fetch_add(p, v, __ATOMIC_RELAXED, __HIP_MEMORY_SCOPE_AGENT); }
__device__ __forceinline__ unsigned xb_xcc_id() { return (unsigned)__builtin_amdgcn_s_getreg((3 << 11) | 20) & 0xFu; }
#define XB_SPIN(cond, bar) do { unsigned _sp = 0; while (cond) { __builtin_amdgcn_s_sleep(1); \
    if ((++_sp & 255u) == 0u) { if (xb_ld(&(bar)[XB_TMO])) break; if (_sp > XB_SPIN_CAP) { atomicAdd(&(bar)[XB_TMO], 1u); break; } } } } while (0)

struct XcdBarrier {
    unsigned* bar; unsigned x;
    volatile LAS unsigned* st;
};

__device__ __forceinline__ XcdBarrier xcd_barrier_post(unsigned* bar, volatile LAS unsigned* st) {
    XcdBarrier b; b.bar = bar; b.x = xb_xcc_id(); b.st = st;
    if (threadIdx.x == 0) (void)xb_add(&bar[XB_XCNT(b.x)], 1u);
    return b;
}
__device__ __forceinline__ void xcd_barrier_complete(unsigned* bar, unsigned x, unsigned& nloc, unsigned& nx) {
    const unsigned G = gridDim.x * gridDim.y * gridDim.z;
    unsigned sum, cnt, mine, sp = 0u;
    for (;;) {
        sum = 0u; cnt = 0u; mine = 0u;
#pragma unroll
        for (unsigned j = 0; j < 16; ++j) { const unsigned c = xb_ld(&bar[XB_XCNT(j)]); sum += c; cnt += (c > 0u) ? 1u : 0u; mine = (j == x) ? c : mine; }
        if (sum == G) break;
        __builtin_amdgcn_s_sleep(1);
        if ((++sp & 255u) == 0u) { if (xb_ld(&bar[XB_TMO])) break; if (sp > XB_SPIN_CAP) { atomicAdd(&bar[XB_TMO], 1u); break; } }
    }
    nloc = mine > 0u ? mine : 1u; nx = cnt > 0u ? cnt : 1u;
}

__device__ __forceinline__ void xcd_barrier(const XcdBarrier& b) {
    asm volatile("s_waitcnt vmcnt(0)" ::: "memory");
    __syncthreads();
    if (threadIdx.x == 0) {
        unsigned* bar = b.bar;
        __builtin_amdgcn_s_waitcnt(0);
        unsigned nloc = b.st[0], nx = b.st[1];
        if (nloc == 0u) { xcd_barrier_complete(bar, b.x, nloc, nx); b.st[0] = nloc; b.st[1] = nx; }
        const unsigned old = xb_add(&bar[XB_XSUB(b.x)], 1u);
        const unsigned gen = old / nloc;
        if (old + 1u == (gen + 1u) * nloc) {
            __builtin_amdgcn_fence(__ATOMIC_RELEASE, "agent");
            asm volatile("s_waitcnt vmcnt(0)" ::: "memory");
            const unsigned og = xb_add(&bar[XB_TOP], 1u);
            const unsigned tg = og / nx;
            if (og + 1u == (tg + 1u) * nx) xb_add(&bar[XB_TOPGEN], 1u);
            else XB_SPIN(xb_ld(&bar[XB_TOPGEN]) == tg, bar);
            __builtin_amdgcn_fence(__ATOMIC_ACQUIRE, "agent");
            xb_add(&bar[XB_XGEN(b.x)], 1u);
            asm volatile("s_waitcnt vmcnt(0)" ::: "memory");
        } else {
            XB_SPIN(xb_ld(&bar[XB_XGEN(b.x)]) == gen, bar);
            __builtin_amdgcn_fence(__ATOMIC_ACQUIRE, "agent");
            asm volatile("s_waitcnt vmcnt(0)" ::: "memory");
        }
    }
    __syncthreads();
}
namespace hg {
typedef short s16x4 __attribute__((ext_vector_type(4)));
typedef short h8 __attribute__((ext_vector_type(8)));
typedef float f4 __attribute__((ext_vector_type(4)));
typedef unsigned u4 __attribute__((ext_vector_type(4)));
typedef unsigned u2 __attribute__((ext_vector_type(2)));
#define HG_LAS __attribute__((address_space(3)))
#define HG_GAS __attribute__((address_space(1)))
__device__ __forceinline__ int FSW(int r) { return ((r & 3) << 1) | ((((r >> 2) ^ (r >> 3)) & 1) << 3) | ((r >> 3) & 1); }
__device__ __forceinline__ int toff(int r, int ch) { return r * 256 + ((ch ^ FSW(r & 15)) << 4); }
__device__ __forceinline__ int aoff(int t, int ch) { return t * 128 + ((ch ^ ((t >> 1) & 7)) << 4); }
__device__ __forceinline__ s16x4 vtr(HG_LAS const unsigned char* p) { return __builtin_bit_cast(s16x4, __builtin_amdgcn_ds_read_tr16_b64_v4i16((HG_LAS s16x4*)p)); }
__device__ __forceinline__ unsigned pkbf(float lo, float hi) { typedef float f2_t __attribute__((ext_vector_type(2))); typedef __bf16 b2_t __attribute__((ext_vector_type(2))); f2_t v = {lo, hi}; b2_t b = __builtin_convertvector(v, b2_t); return __builtin_bit_cast(unsigned, b); }
constexpr int OFF_QD = 0, OFF_KI = 16384, OFF_V = 32768, OFF_ATT = 49152, OFF_D = 57344, OFF_OST = 57856, OST_LD = 132;
constexpr int SEQ_ = 4096, NCH = 64, SCH = 8, NSC = 8;

__device__ __forceinline__ void chain(HG_LAS unsigned char* L, int b, int h, int sc, const float* AS, const float* DS, const unsigned short* QD, const unsigned short* KI, const float* DL, const unsigned short* HV, const unsigned short* GH, unsigned short* MIXED, const float* hgrn_w, float eps) {
    int tid_ = threadIdx.x; asm volatile("" : "+v"(tid_));
    const int tid = tid_, lane = tid & 63, wave = __builtin_amdgcn_readfirstlane(tid >> 6);
    const int l15 = lane & 15, g = lane >> 4, q4 = l15 >> 2, p4 = l15 & 3;
    const int r0 = tid >> 4, ch0 = tid & 15, r1 = r0 + 32;
    const size_t tok0 = (size_t)b * SEQ_;
    const int lo0 = toff(r0, ch0), lo1 = toff(r1, ch0);
    const int et = tid >> 3, ep = tid & 7;
    f4 wv[4];
#pragma unroll
    for (int i = 0; i < 4; ++i) wv[i] = *(const HG_GAS f4*)(hgrn_w + h * 128 + 16 * ep + 4 * i);
    u4 pq0, pq1, pk0, pk1, pv0, pv1; f4 pd = {0.f, 0.f, 0.f, 0.f};
#define HG_LOAD(c) do { const size_t ta = tok0 + (size_t)(c) * 64 + r0, tb = ta + 32; \
        pq0 = *(const HG_GAS u4*)(QD + ta * 512 + h * 128 + ch0 * 8); pq1 = *(const HG_GAS u4*)(QD + tb * 512 + h * 128 + ch0 * 8); \
        pk0 = *(const HG_GAS u4*)(KI + ta * 512 + h * 128 + ch0 * 8); pk1 = *(const HG_GAS u4*)(KI + tb * 512 + h * 128 + ch0 * 8); \
        pv0 = *(const HG_GAS u4*)(HV + ta * 512 + h * 128 + ch0 * 8); pv1 = *(const HG_GAS u4*)(HV + tb * 512 + h * 128 + ch0 * 8); \
        if (tid < 32) pd = *(const HG_GAS f4*)(DL + ((size_t)b * NCH + (c)) * 512 + h * 128 + tid * 4); } while (0)
#define HG_STORE() do { *(HG_LAS u4*)(L + OFF_QD + lo0) = pq0; *(HG_LAS u4*)(L + OFF_QD + lo1) = pq1; *(HG_LAS u4*)(L + OFF_KI + lo0) = pk0; *(HG_LAS u4*)(L + OFF_KI + lo1) = pk1; \
        *(HG_LAS u4*)(L + OFF_V + lo0) = pv0; *(HG_LAS u4*)(L + OFF_V + lo1) = pv1; if (tid < 32) *(HG_LAS f4*)(L + OFF_D + tid * 16) = pd; } while (0)
    const int cbeg = sc * SCH, cend = cbeg + SCH;
    HG_LOAD(cbeg); HG_STORE();
    __syncthreads();
    f4 S[8];
#pragma unroll
    for (int a = 0; a < 8; ++a) S[a] = (f4){0.f, 0.f, 0.f, 0.f};
    for (int sp = 0; sp < sc; ++sp) {
        const size_t up = (size_t)(b * 4 + h) * NSC + sp;
#pragma unroll
        for (int a = 0; a < 8; ++a) { const f4 dv = *(const HG_GAS f4*)(DS + up * 128 + 16 * a + 4 * g); const f4 av = *(const HG_GAS f4*)(AS + ((up * 8 + wave) * 8 + a) * 256 + lane * 4); S[a] = S[a] * dv + av; }
    }
    for (int c = cbeg; c < cend; ++c) {
        if (c + 1 < cend) HG_LOAD(c + 1);
        const size_t etok = tok0 + (size_t)c * 64 + et;
        const u4 gt0 = *(const HG_GAS u4*)(GH + etok * 512 + h * 128 + 16 * ep), gt1 = *(const HG_GAS u4*)(GH + etok * 512 + h * 128 + 16 * ep + 8);
        { const int ti = wave >> 1;
#pragma unroll
          for (int sx = 0; sx < 2; ++sx) { const int si = 2 * (wave & 1) + sx; f4 acc = {0.f, 0.f, 0.f, 0.f};
#pragma unroll
              for (int ks = 0; ks < 4; ++ks) { const h8 a = *(const HG_LAS h8*)(L + OFF_KI + toff(16 * si + l15, 4 * ks + g)); const h8 bq = *(const HG_LAS h8*)(L + OFF_QD + toff(16 * ti + l15, 4 * ks + g));
                  acc = __builtin_amdgcn_mfma_f32_16x16x32_bf16(a, bq, acc, 0, 0, 0); }
              const int t = 16 * ti + l15, s0 = 16 * si + 4 * g;
              const float v0 = (s0 + 0 <= t) ? acc[0] : 0.f, v1 = (s0 + 1 <= t) ? acc[1] : 0.f, v2 = (s0 + 2 <= t) ? acc[2] : 0.f, v3 = (s0 + 3 <= t) ? acc[3] : 0.f;
              u2 w; w.x = pkbf(v0, v1); w.y = pkbf(v2, v3);
              *(HG_LAS u2*)(L + OFF_ATT + aoff(t, s0 >> 3) + (s0 & 7) * 2) = w; } }
        h8 vf[2];
#pragma unroll
        for (int ks = 0; ks < 2; ++ks) { const int rr = 32 * ks + 8 * g + q4;
            const s16x4 lo = vtr(L + OFF_V + toff(rr, 2 * wave + (p4 >> 1)) + 8 * (p4 & 1)), hi = vtr(L + OFF_V + toff(rr + 4, 2 * wave + (p4 >> 1)) + 8 * (p4 & 1));
            vf[ks] = (h8){lo[0], lo[1], lo[2], lo[3], hi[0], hi[1], hi[2], hi[3]}; }
        h8 sb[4];
#pragma unroll
        for (int ap = 0; ap < 4; ++ap) { u4 w; w.x = pkbf(S[2 * ap][0], S[2 * ap][1]); w.y = pkbf(S[2 * ap][2], S[2 * ap][3]); w.z = pkbf(S[2 * ap + 1][0], S[2 * ap + 1][1]); w.w = pkbf(S[2 * ap + 1][2], S[2 * ap + 1][3]); sb[ap] = __builtin_bit_cast(h8, w); }
        f4 O[4];
#pragma unroll
        for (int tt = 0; tt < 4; ++tt) { O[tt] = (f4){0.f, 0.f, 0.f, 0.f};
#pragma unroll
            for (int ap = 0; ap < 4; ++ap) { const int row = 16 * tt + l15;
                const u2 x0 = *(const HG_LAS u2*)(L + OFF_QD + toff(row, 4 * ap + (g >> 1)) + 8 * (g & 1)), x1 = *(const HG_LAS u2*)(L + OFF_QD + toff(row, 4 * ap + 2 + (g >> 1)) + 8 * (g & 1));
                u4 w; w.x = x0.x; w.y = x0.y; w.z = x1.x; w.w = x1.y;
                O[tt] = __builtin_amdgcn_mfma_f32_16x16x32_bf16(__builtin_bit_cast(h8, w), sb[ap], O[tt], 0, 0, 0); } }
#pragma unroll
        for (int a = 0; a < 8; ++a) {
#pragma unroll
            for (int ks = 0; ks < 2; ++ks) { const int rr = 32 * ks + 8 * g + q4;
                const s16x4 lo = vtr(L + OFF_KI + toff(rr, 2 * a + (p4 >> 1)) + 8 * (p4 & 1)), hi = vtr(L + OFF_KI + toff(rr + 4, 2 * a + (p4 >> 1)) + 8 * (p4 & 1));
                const h8 kf = (h8){lo[0], lo[1], lo[2], lo[3], hi[0], hi[1], hi[2], hi[3]};
                S[a] = __builtin_amdgcn_mfma_f32_16x16x32_bf16(kf, vf[ks], S[a], 0, 0, 0); }
            const f4 dv = *(const HG_LAS f4*)(L + OFF_D + (16 * a + 4 * g) * 4);
            S[a] = S[a] * dv; }
        __syncthreads();
#pragma unroll
        for (int tt = 0; tt < 4; ++tt)
#pragma unroll
            for (int ks = 0; ks < 2; ++ks) { const h8 a = *(const HG_LAS h8*)(L + OFF_ATT + aoff(16 * tt + l15, 4 * ks + g)); O[tt] = __builtin_amdgcn_mfma_f32_16x16x32_bf16(a, vf[ks], O[tt], 0, 0, 0); }
#pragma unroll
        for (int tt = 0; tt < 4; ++tt)
#pragma unroll
            for (int r = 0; r < 4; ++r) *(HG_LAS float*)(L + OFF_OST + ((16 * tt + 4 * g + r) * OST_LD + 16 * wave + l15) * 4) = O[tt][r];
        __syncthreads();
        { f4 o[4]; float ss = 0.f;
#pragma unroll
          for (int i = 0; i < 4; ++i) { o[i] = *(const HG_LAS f4*)(L + OFF_OST + (et * OST_LD + 16 * ep + 4 * i) * 4); ss += (o[i][0] * o[i][0] + o[i][1] * o[i][1]) + (o[i][2] * o[i][2] + o[i][3] * o[i][3]); }
          ss += __shfl_xor(ss, 1); ss += __shfl_xor(ss, 2); ss += __shfl_xor(ss, 4);
          const float rstd = 1.0f / sqrtf(ss * (1.0f / 128.0f) + eps);
          float y[16];
          const unsigned gw_[8] = {gt0.x, gt0.y, gt0.z, gt0.w, gt1.x, gt1.y, gt1.z, gt1.w};
#pragma unroll
          for (int i = 0; i < 16; ++i) { const float gv = (i & 1) ? __uint_as_float(gw_[i >> 1] & 0xffff0000u) : __uint_as_float(gw_[i >> 1] << 16);
              y[i] = o[i >> 2][i & 3] * rstd * wv[i >> 2][i & 3] * gv; }
          u4 w0, w1; w0.x = pkbf(y[0], y[1]); w0.y = pkbf(y[2], y[3]); w0.z = pkbf(y[4], y[5]); w0.w = pkbf(y[6], y[7]); w1.x = pkbf(y[8], y[9]); w1.y = pkbf(y[10], y[11]); w1.z = pkbf(y[12], y[13]); w1.w = pkbf(y[14], y[15]);
          *(HG_GAS u4*)(MIXED + etok * 1024 + 512 + h * 128 + 16 * ep) = w0; *(HG_GAS u4*)(MIXED + etok * 1024 + 512 + h * 128 + 16 * ep + 8) = w1; }
        if (c + 1 < cend) HG_STORE();
        __syncthreads();
    }
#undef HG_LOAD
#undef HG_STORE
}

__device__ __forceinline__ void state_pass(HG_LAS unsigned char* L, int b, int h, int sc, const unsigned short* KI, const float* DL, const unsigned short* HV, float* AS, float* DS) {
    int tid_ = threadIdx.x; asm volatile("" : "+v"(tid_));
    const int tid = tid_, lane = tid & 63, wave = __builtin_amdgcn_readfirstlane(tid >> 6);
    const int l15 = lane & 15, g = lane >> 4, q4 = l15 >> 2, p4 = l15 & 3;
    const int r0 = tid >> 4, ch0 = tid & 15, r1 = r0 + 32;
    const size_t tok0 = (size_t)b * SEQ_;
    const int lo0 = toff(r0, ch0), lo1 = toff(r1, ch0);
    constexpr int BUFB = 33280, PK = 0, PV = 16384, PD = 32768;
    u4 pk0, pk1, pv0, pv1; f4 pd = {0.f, 0.f, 0.f, 0.f};
#define SP_LOAD(c) do { const size_t ta = tok0 + (size_t)(c) * 64 + r0, tb = ta + 32; \
        pk0 = *(const HG_GAS u4*)(KI + ta * 512 + h * 128 + ch0 * 8); pk1 = *(const HG_GAS u4*)(KI + tb * 512 + h * 128 + ch0 * 8); \
        pv0 = *(const HG_GAS u4*)(HV + ta * 512 + h * 128 + ch0 * 8); pv1 = *(const HG_GAS u4*)(HV + tb * 512 + h * 128 + ch0 * 8); \
        if (tid < 32) pd = *(const HG_GAS f4*)(DL + ((size_t)b * NCH + (c)) * 512 + h * 128 + tid * 4); } while (0)
#define SP_STORE(base) do { *(HG_LAS u4*)(L + (base) + PK + lo0) = pk0; *(HG_LAS u4*)(L + (base) + PK + lo1) = pk1; *(HG_LAS u4*)(L + (base) + PV + lo0) = pv0; *(HG_LAS u4*)(L + (base) + PV + lo1) = pv1; \
        if (tid < 32) *(HG_LAS f4*)(L + (base) + PD + tid * 16) = pd; } while (0)
    const int cbeg = sc * SCH;
    SP_LOAD(cbeg); SP_STORE(0);
    __syncthreads();
    f4 S[8];
#pragma unroll
    for (int a = 0; a < 8; ++a) S[a] = (f4){0.f, 0.f, 0.f, 0.f};
    float dprod = 1.0f;
    for (int i = 0; i < SCH; ++i) {
        if (i + 1 < SCH) SP_LOAD(cbeg + i + 1);
        const int base = (i & 1) * BUFB;
        h8 vf[2];
#pragma unroll
        for (int ks = 0; ks < 2; ++ks) { const int rr = 32 * ks + 8 * g + q4;
            const s16x4 lo = vtr(L + base + PV + toff(rr, 2 * wave + (p4 >> 1)) + 8 * (p4 & 1)), hi = vtr(L + base + PV + toff(rr + 4, 2 * wave + (p4 >> 1)) + 8 * (p4 & 1));
            vf[ks] = (h8){lo[0], lo[1], lo[2], lo[3], hi[0], hi[1], hi[2], hi[3]}; }
#pragma unroll
        for (int a = 0; a < 8; ++a) {
#pragma unroll
            for (int ks = 0; ks < 2; ++ks) { const int rr = 32 * ks + 8 * g + q4;
                const s16x4 lo = vtr(L + base + PK + toff(rr, 2 * a + (p4 >> 1)) + 8 * (p4 & 1)), hi = vtr(L + base + PK + toff(rr + 4, 2 * a + (p4 >> 1)) + 8 * (p4 & 1));
                const h8 kf = (h8){lo[0], lo[1], lo[2], lo[3], hi[0], hi[1], hi[2], hi[3]};
                S[a] = __builtin_amdgcn_mfma_f32_16x16x32_bf16(kf, vf[ks], S[a], 0, 0, 0); }
            const f4 dv = *(const HG_LAS f4*)(L + base + PD + (16 * a + 4 * g) * 4);
            S[a] = S[a] * dv; }
        if (tid < 128) dprod *= *(const HG_LAS float*)(L + base + PD + tid * 4);
        if (i + 1 < SCH) SP_STORE(((i + 1) & 1) * BUFB);
        __syncthreads();
    }
#undef SP_LOAD
#undef SP_STORE
    const size_t un = (size_t)(b * 4 + h) * NSC + sc;
#pragma unroll
    for (int a = 0; a < 8; ++a) *(HG_GAS f4*)(AS + ((un * 8 + wave) * 8 + a) * 256 + lane * 4) = S[a];
    if (tid < 128) DS[un * 128 + tid] = dprod;
}
}
namespace at {
typedef short h8 __attribute__((ext_vector_type(8)));
typedef short s16x4 __attribute__((ext_vector_type(4)));
typedef float f16v __attribute__((ext_vector_type(16)));
typedef unsigned u2 __attribute__((ext_vector_type(2)));
typedef unsigned u4 __attribute__((ext_vector_type(4)));
#define AT_LAS __attribute__((address_space(3)))
#define AT_GAS __attribute__((address_space(1)))
constexpr int SEQ_ = 4096, TT = 32768;
constexpr float C2 = 0.18033688011112042f;
__device__ __forceinline__ int GSW(int row) { const int P = row >> 1; return ((P & 1) << 2) | ((P >> 1) & 3); }
__device__ __forceinline__ s16x4 vtr(AT_LAS const unsigned char* p) { return __builtin_bit_cast(s16x4, __builtin_amdgcn_ds_read_tr16_b64_v4i16((AT_LAS s16x4*)p)); }
__device__ __forceinline__ unsigned pkbf(float lo, float hi) { typedef float f2_t __attribute__((ext_vector_type(2))); typedef __bf16 b2_t __attribute__((ext_vector_type(2))); f2_t v = {lo, hi}; b2_t b = __builtin_convertvector(v, b2_t); return __builtin_bit_cast(unsigned, b); }

__device__ __forceinline__ void unit(AT_LAS unsigned char* Lw, int p, int b, int h, int r, int u, const unsigned short* Q, const unsigned short* K, const unsigned short* V,
                                     unsigned short* PART, float* ML) {
    int lane = threadIdx.x & 63; asm volatile("" : "+v"(lane));
    constexpr int qpitch = 512, kpitch = 512, vpitch = 512;
    const int a = lane & 31, hh = lane >> 5, dl = (p == 0) ? 1 : (p == 1) ? 4 : 16;
    const int tokbase = b * SEQ_ + r, i0 = 64 * u;
    h8 qf[2][4];
#pragma unroll
    for (int g = 0; g < 2; ++g)
#pragma unroll
        for (int ks = 0; ks < 4; ++ks) qf[g][ks] = *(const AT_GAS h8*)(Q + (size_t)(tokbase + dl * (i0 + 32 * g + a)) * qpitch + h * 64 + 16 * ks + 8 * hh);
    f16v o[2][2]; float m[2], ls[2];
#pragma unroll
    for (int g = 0; g < 2; ++g) { m[g] = -1e30f; ls[g] = 0.f;
#pragma unroll
        for (int dt = 0; dt < 2; ++dt)
#pragma unroll
            for (int i = 0; i < 16; ++i) o[g][dt][i] = 0.f; }
    const int jlo = (u == 0) ? 4 : (u == 1) ? 2 : 0;
    const int drow = lane >> 3, dcp = lane & 7;
#define AT_DMA(j, bb) do { const int ik0_ = i0 - 128 + 32 * (j); _Pragma("unroll") for (int n_ = 0; n_ < 4; ++n_) { const int row_ = 8 * n_ + drow; const int c_ = dcp ^ GSW(row_); \
        const size_t tok_ = (size_t)(tokbase + dl * (ik0_ + row_)); \
        __builtin_amdgcn_global_load_lds((const unsigned*)(K + tok_ * kpitch + h * 64 + c_ * 8), (AT_LAS unsigned*)(Lw + (bb) * 8192 + n_ * 1024), 16, 0, 0); \
        __builtin_amdgcn_global_load_lds((const unsigned*)(V + tok_ * vpitch + h * 64 + c_ * 8), (AT_LAS unsigned*)(Lw + (bb) * 8192 + 4096 + n_ * 1024), 16, 0, 0); } } while (0)
    asm volatile("" ::: "memory");
    AT_DMA(jlo, 0);
    const int grp = lane >> 4, i15 = lane & 15, q4 = i15 >> 2, p4 = i15 & 3;
    for (int j = jlo; j < 6; ++j) {
        const int bb = (j - jlo) & 1;
        asm volatile("s_waitcnt vmcnt(0)" ::: "memory");
        if (j + 1 < 6) AT_DMA(j + 1, bb ^ 1);
        asm volatile("" ::: "memory");
        AT_LAS const unsigned char* Kt = Lw + bb * 8192; AT_LAS const unsigned char* Vt = Kt + 4096;
#pragma unroll
        for (int g = 0; g < 2; ++g) {
            if ((g == 0 && j <= 4) || (g == 1 && j >= 1)) {
                f16v s;
#pragma unroll
                for (int i = 0; i < 16; ++i) s[i] = 0.f;
#pragma unroll
                for (int ks = 0; ks < 4; ++ks) { const h8 kf = *(const AT_LAS h8*)(Kt + a * 128 + (((2 * ks + hh) ^ GSW(a)) << 4)); s = __builtin_amdgcn_mfma_f32_32x32x16_bf16(kf, qf[g][ks], s, 0, 0, 0); }
                const bool lowb = (j == g), highb = (j == g + 4);
                float mx = -1e30f;
#pragma unroll
                for (int i = 0; i < 16; ++i) { const int kb = (i & 3) + 8 * (i >> 2) + 4 * hh; float x = s[i]; if (lowb && kb < a) x = -1e30f; if (highb && kb > a) x = -1e30f; s[i] = x; mx = fmaxf(mx, x); }
                mx = fmaxf(mx, __shfl_xor(mx, 32));
                const float mn = fmaxf(m[g], mx), alpha = __builtin_amdgcn_exp2f(m[g] - mn); m[g] = mn;
                float rs = 0.f;
#pragma unroll
                for (int i = 0; i < 16; ++i) { s[i] = __builtin_amdgcn_exp2f(s[i] - mn); rs += s[i]; }
                ls[g] = ls[g] * alpha + rs;
#pragma unroll
                for (int dt = 0; dt < 2; ++dt)
#pragma unroll
                    for (int i = 0; i < 16; ++i) o[g][dt][i] *= alpha;
                h8 pb[2];
#pragma unroll
                for (int k2 = 0; k2 < 2; ++k2) { u4 w; w.x = pkbf(s[8 * k2 + 0], s[8 * k2 + 1]); w.y = pkbf(s[8 * k2 + 2], s[8 * k2 + 3]); w.z = pkbf(s[8 * k2 + 4], s[8 * k2 + 5]); w.w = pkbf(s[8 * k2 + 6], s[8 * k2 + 7]); pb[k2] = __builtin_bit_cast(h8, w); }
#pragma unroll
                for (int dt = 0; dt < 2; ++dt)
#pragma unroll
                    for (int k2 = 0; k2 < 2; ++k2) { const int row = 16 * k2 + 4 * hh + q4; const int chk = 4 * dt + 2 * (grp & 1) + (p4 >> 1);
                        const s16x4 lo = vtr(Vt + row * 128 + ((chk ^ GSW(row)) << 4) + 8 * (p4 & 1)), hi = vtr(Vt + (row + 8) * 128 + ((chk ^ GSW(row + 8)) << 4) + 8 * (p4 & 1));
                        const h8 vf = (h8){lo[0], lo[1], lo[2], lo[3], hi[0], hi[1], hi[2], hi[3]};
                        o[g][dt] = __builtin_amdgcn_mfma_f32_32x32x16_bf16(vf, pb[k2], o[g][dt], 0, 0, 0); }
            }
        }
    }
#undef AT_DMA
#pragma unroll
    for (int g = 0; g < 2; ++g) {
        const float lt = ls[g] + __shfl_xor(ls[g], 32); const float inv = 1.0f / lt;
        const size_t rec = ((size_t)p * TT + (size_t)(tokbase + dl * (i0 + 32 * g + a))) * 8 + h;
#pragma unroll
        for (int dt = 0; dt < 2; ++dt)
#pragma unroll
            for (int rq = 0; rq < 4; ++rq) { u2 w; w.x = pkbf(o[g][dt][4 * rq] * inv, o[g][dt][4 * rq + 1] * inv); w.y = pkbf(o[g][dt][4 * rq + 2] * inv, o[g][dt][4 * rq + 3] * inv);
                *(AT_GAS u2*)(PART + rec * 64 + 32 * dt + 8 * rq + 4 * hh) = w; }
        if (hh == 0) { typedef float f2 __attribute__((ext_vector_type(2))); *(AT_GAS f2*)(ML + rec * 2) = (f2){m[g], lt}; }
    }
}
}
constexpr int NWAVES = 8;
constexpr int BATCH = 8, SEQ = 4096, DMODEL = 1024, T = BATCH * SEQ, INC = 4096;
constexpr float NORM_EPS = 1e-6f;
constexpr size_t MiB = 1u << 20;
constexpr size_t WS_CTL = 0, CTL_ZERO_BYTES = 1 * MiB;
constexpr size_t WS_WIN = 2 * MiB, WS_WOUT = 10 * MiB, WS_SSQ = 12 * MiB, WS_DL = 14 * MiB, WS_CS = 15 * MiB;
constexpr size_t WS_XN = 32 * MiB;
constexpr size_t WS_PART = 32 * MiB;
constexpr size_t WS_Q = 128 * MiB, WS_K = 160 * MiB, WS_V = 192 * MiB, WS_GA = 224 * MiB, WS_QD = 256 * MiB, WS_KI = 288 * MiB, WS_HV = 320 * MiB, WS_GH = 352 * MiB;
constexpr size_t WS_MIXED = 384 * MiB, WS_ML = 448 * MiB, WS_AS = 454 * MiB, WS_DS = 470 * MiB, WS_END = 471 * MiB;
constexpr int CW_ATTN_CTR = 64;
constexpr int CW_BAR = 4096;
constexpr int RING_OFF = 0, RING_BYTES = 131072;
constexpr int LDSCTL_OFF = RING_BYTES, MISC_OFF = LDSCTL_OFF + 320;
constexpr int LDS_BYTES = 147456;

__device__ __forceinline__ float bf2f(unsigned short u) { return __uint_as_float(((unsigned)u) << 16); }
__device__ __forceinline__ float sigmoidf_(float x) { return 1.0f / (1.0f + __expf(-x)); }
__device__ __forceinline__ float wave_sum(float v) {
#pragma unroll
    for (int o = 1; o < 64; o <<= 1) v += __shfl_xor(v, o);
    return v;
}
__device__ __forceinline__ float wave_max(float v) {
#pragma unroll
    for (int o = 1; o < 64; o <<= 1) v = fmaxf(v, __shfl_xor(v, o));
    return v;
}
__device__ __forceinline__ float inv_freq(int i) {
    return i == 0 ? 1.0f : i == 1 ? 0.19392274474868576f : i == 2 ? 0.03760603093086393f : i == 3 ? 0.007292664737217109f :
           i == 4 ? 0.001414213562373095f : i == 5 ? 0.0002742481756762073f : i == 6 ? 5.318295896944988e-05f : 1.031338537721246e-05f;
}

struct Args { const float* x; const int* pos; const float* w_in; const float* w_out; const float* mix_w; const float* attn_w; const float* hgrn_w; const float* lb_raw; const float* fin_w; float* out; unsigned char* ws; };

__device__ __forceinline__ int orig_col(int n) {
    if (n < 1024) { const int pc = n & 63; return (pc < 16) ? (n & ~63) + (pc & 3) + 4 * (pc >> 3) + 8 * ((pc >> 2) & 1) : n; }
    if (n >= 2048 && n < 3072) { const int t = n - 2048, h = t >> 8, w = t & 255; return (w < 128) ? 2048 + 128 * h + w : 2560 + 128 * h + (w - 128); }
    return n;
}
template <bool PERMUTE>
__device__ __forceinline__ void p0_transpose_item(const float* W, int K, int N, bf16* WT, const float* gain, LAS float* scr, int item, int lane) {
    const int nblk = N / 32, kb = item / nblk, nb = item % nblk, k0 = 64 * kb, n0 = 32 * nb;
#pragma unroll 8
    for (int i = 0; i < 32; ++i) { const int kk = 2 * i + (lane >> 5); const int ncol = PERMUTE ? orig_col(n0 + (lane & 31)) : n0 + (lane & 31); float w = W[(size_t)(k0 + kk) * N + ncol]; if (gain) w *= gain[k0 + kk]; scr[kk * 33 + (lane & 31)] = w; }
    LDS_WAIT(); asm volatile("" ::: "memory");
    const int c = lane & 7;
#pragma unroll
    for (int j = 0; j < 4; ++j) { const int n = (lane >> 3) + 8 * j; const LAS float* s = scr + (8 * c) * 33 + n;
        v4u o; o.x = pk2(s[0 * 33], s[1 * 33]); o.y = pk2(s[2 * 33], s[3 * 33]); o.z = pk2(s[4 * 33], s[5 * 33]); o.w = pk2(s[6 * 33], s[7 * 33]);
        *(GAS v4u*)(WT + (size_t)(n0 + n) * K + k0 + 8 * c) = o; }
    LDS_WAIT(); asm volatile("" ::: "memory");
}

__global__ void __launch_bounds__(NWAVES * 64, 2) fwd_kernel(Args A) {
    extern __shared__ __attribute__((aligned(16))) unsigned char lds[];
    LAS unsigned char* L = (LAS unsigned char*)lds;
    volatile LAS unsigned* MISC = (volatile LAS unsigned*)(L + MISC_OFF);
    const int tid = threadIdx.x, lane = tid & 63, wave = __builtin_amdgcn_readfirstlane(tid >> 6);
    const int G = gridDim.x, bx = blockIdx.x;
    const int vcu = (G % 8 == 0) ? (bx % 8) * (G / 8) + bx / 8 : bx;
    unsigned char* ws = A.ws;
    gu32* ctl = (gu32*)(ws + WS_CTL);
    bf16* WinT = (bf16*)(ws + WS_WIN); bf16* WoT = (bf16*)(ws + WS_WOUT); float* SSQ = (float*)(ws + WS_SSQ); float* DL = (float*)(ws + WS_DL); float* CS = (float*)(ws + WS_CS);
    bf16* XN = (bf16*)(ws + WS_XN); bf16* PART = (bf16*)(ws + WS_PART); float* ML = (float*)(ws + WS_ML);
    bf16* QB = (bf16*)(ws + WS_Q); bf16* KB = (bf16*)(ws + WS_K); bf16* VB = (bf16*)(ws + WS_V); bf16* GA = (bf16*)(ws + WS_GA);
    bf16* QD = (bf16*)(ws + WS_QD); bf16* KI = (bf16*)(ws + WS_KI); bf16* HV = (bf16*)(ws + WS_HV); bf16* GH = (bf16*)(ws + WS_GH); bf16* MIXED = (bf16*)(ws + WS_MIXED);
    float* AS = (float*)(ws + WS_AS); float* DS = (float*)(ws + WS_DS);
    for (int u = tid; u < (LDS_BYTES - LDSCTL_OFF) / 4; u += NWAVES * 64) ((LAS unsigned*)(L + LDSCTL_OFF))[u] = 0u;
    __syncthreads();
    XcdBarrier bar = xcd_barrier_post((unsigned*)(ctl + CW_BAR), MISC + 8);
    const int gw = vcu * NWAVES + wave, NGW = G * NWAVES;

    {
        LAS float* scr = (LAS float*)(L + RING_OFF + wave * 16384);
        constexpr int I_IN = (DMODEL / 64) * (INC / 32), I_OUT = (DMODEL / 64) * (DMODEL / 32);
        for (int it = gw; it < I_IN + I_OUT; it += NGW) {
            if (it < I_IN) p0_transpose_item<true>(A.w_in, DMODEL, INC, WinT, A.mix_w, scr, it, lane);
            else p0_transpose_item<false>(A.w_out, DMODEL, DMODEL, WoT, nullptr, scr, it - I_IN, lane);
        }
        for (int m = gw; m < T; m += NGW) {
            const GAS f32x4* xr = (const GAS f32x4*)(A.x + (size_t)m * DMODEL) + lane;
            f32x4 v[4]; float s = 0.f;
#pragma unroll
            for (int j = 0; j < 4; ++j) { v[j] = xr[64 * j]; s += (v[j].x * v[j].x + v[j].y * v[j].y) + (v[j].z * v[j].z + v[j].w * v[j].w); }
            const float rstd = 1.f / sqrtf(wave_sum(s) * (1.f / DMODEL) + NORM_EPS);
            GAS unsigned long long* o8 = (GAS unsigned long long*)(XN + (size_t)m * DMODEL) + lane;
#pragma unroll
            for (int j = 0; j < 4; ++j) o8[64 * j] = (unsigned long long)pk2(v[j].x * rstd, v[j].y * rstd) | ((unsigned long long)pk2(v[j].z * rstd, v[j].w * rstd) << 32);
        }
        for (int it = (vcu * NWAVES * 64) + tid; it < T * 8; it += G * NWAVES * 64) {
            const int tok = it >> 3, i = it & 7; float sn, cs; sincosf((float)A.pos[tok] * inv_freq(i), &sn, &cs);
            CS[(size_t)tok * 16 + i] = cs; CS[(size_t)tok * 16 + 8 + i] = sn;
        }
    }
    xcd_barrier(bar);
    {
        pg8::Gemm g{XN, WinT, T, INC, DMODEL}; pg8::StaticOrder S; S.init(T, INC, G, bx);
        pg8::EpiProj E{QB, DL, CS, A.lb_raw, at::C2};
        pg8::gemm_phase<pg8::EpiProj, pg8::StaticOrder, true, true>(L + RING_OFF, g, S, E);
    }
    xcd_barrier(bar);
    for (int un = bx; un < 32 * 7; un += G) { const int bh = un / 7, sc = un % 7; hg::state_pass(L + RING_OFF, bh >> 2, bh & 3, sc, KI, DL, HV, AS, DS); }
    {
        LAS unsigned char* Lw = L + RING_OFF + wave * 16384;
        for (;;) {
            int id = 0; if (lane == 0) id = (int)__hip_atomic_fetch_add((unsigned*)(ctl + CW_ATTN_CTR), 1u, __ATOMIC_RELAXED, __HIP_MEMORY_SCOPE_AGENT);
            id = __builtin_amdgcn_readfirstlane(id);
            if (id >= 64 * 192) break;
            const int bh = id / 192, rem = id % 192, p = rem >> 6, w = rem & 63;
            const int dl = (p == 0) ? 1 : (p == 1) ? 4 : 16; const int nu = 64 / dl;
            const int r = w / nu, u = w % nu;
            at::unit(Lw, p, bh >> 3, bh & 7, r, u, QB, KB, VB, PART, ML);
        }
    }
    xcd_barrier(bar);
    for (int un = bx; un < 32 * 8; un += G) { const int bh = un >> 3, sc = un & 7; hg::chain(L + RING_OFF, bh >> 2, bh & 3, sc, AS, DS, QD, KI, DL, HV, GH, MIXED, A.hgrn_w, NORM_EPS); }
    for (int tok = gw; tok < T; tok += NGW) {
        const int h = lane >> 3, dc = lane & 7;
        float mm[3], ll[3]; v4u ov[3];
#pragma unroll
        for (int p = 0; p < 3; ++p) { const size_t rec = ((size_t)p * T + tok) * 8 + h; typedef float f2 __attribute__((ext_vector_type(2))); const f2 ml = *(const GAS f2*)(ML + rec * 2); mm[p] = ml.x; ll[p] = ml.y;
            ov[p] = *(const GAS v4u*)(PART + rec * 64 + 8 * dc); }
        const float M = fmaxf(fmaxf(mm[0], mm[1]), mm[2]);
        float wgt[3]; float den = 0.f;
#pragma unroll
        for (int p = 0; p < 3; ++p) { wgt[p] = __builtin_amdgcn_exp2f(mm[p] - M) * ll[p]; den += wgt[p]; }
        const float rden = 1.0f / den;
        float at_[8]; float ss = 0.f;
#pragma unroll
        for (int i = 0; i < 8; ++i) { float acc = 0.f;
#pragma unroll
            for (int p = 0; p < 3; ++p) { const unsigned wd = (i >> 1) == 0 ? ov[p].x : (i >> 1) == 1 ? ov[p].y : (i >> 1) == 2 ? ov[p].z : ov[p].w; const float v = (i & 1) ? __uint_as_float(wd & 0xffff0000u) : __uint_as_float(wd << 16); acc += wgt[p] * v; }
            at_[i] = acc * rden; ss += at_[i] * at_[i]; }
        ss += __shfl_xor(ss, 1); ss += __shfl_xor(ss, 2); ss += __shfl_xor(ss, 4);
        const float rstd = 1.0f / sqrtf(ss * (1.0f / 64.0f) + NORM_EPS);
        const v4u gt = *(const GAS v4u*)(GA + (size_t)tok * 512 + h * 64 + 8 * dc);
        const f32x4 w0 = *(const GAS f32x4*)(A.attn_w + h * 64 + 8 * dc), w1 = *(const GAS f32x4*)(A.attn_w + h * 64 + 8 * dc + 4);
        float y[8];
#pragma unroll
        for (int i = 0; i < 8; ++i) { const unsigned wd = (i >> 1) == 0 ? gt.x : (i >> 1) == 1 ? gt.y : (i >> 1) == 2 ? gt.z : gt.w; const float gv = (i & 1) ? __uint_as_float(wd & 0xffff0000u) : __uint_as_float(wd << 16);
            y[i] = at_[i] * rstd * (i < 4 ? w0[i & 3] : w1[i & 3]) * gv; }
        v4u o; o.x = pk2(y[0], y[1]); o.y = pk2(y[2], y[3]); o.z = pk2(y[4], y[5]); o.w = pk2(y[6], y[7]);
        *(GAS v4u*)(MIXED + (size_t)tok * DMODEL + h * 64 + 8 * dc) = o;
    }
    xcd_barrier(bar);
    {
        pg8::Gemm g{MIXED, WoT, T, DMODEL, DMODEL}; pg8::StaticOrder S; S.init(T, DMODEL, G, bx);
        pg8::EpiOut E{A.x, A.out, SSQ};
        pg8::gemm_phase<pg8::EpiOut, pg8::StaticOrder, true, true>(L + RING_OFF, g, S, E);
    }
    xcd_barrier(bar);
    for (int m = gw; m < T; m += NGW) {
        float s = (lane < 16) ? SSQ[(size_t)m * 16 + lane] : 0.f; s = wave_sum(s);
        const float rstd = 1.f / sqrtf(s * (1.f / DMODEL) + NORM_EPS);
        GAS f32x4* xr = (GAS f32x4*)(A.out + (size_t)m * DMODEL) + lane; const GAS f32x4* wr_ = (const GAS f32x4*)A.fin_w + lane;
#pragma unroll
        for (int j = 0; j < 4; ++j) { f32x4 v = xr[64 * j]; const f32x4 w = wr_[64 * j]; v = v * rstd * w; xr[64 * j] = v; }
    }
}

extern "C" void kernel_launch(void* const* d_in, const int* in_sizes, int n_in, void* d_out, int out_size, void* d_ws, size_t ws_size, hipStream_t stream) {
    static int grid = 0;
    if (grid == 0) {
        if (n_in != 9 || in_sizes[0] != T * DMODEL || out_size != T * DMODEL || ws_size < WS_END) { fprintf(stderr, "kernel_launch: unexpected shapes/ws (n_in %d, ws %zu)\n", n_in, ws_size); grid = -1; return; }
        int dev = 0, cus = 0, per_cu = 0;
        if (hipGetDevice(&dev) != hipSuccess || hipDeviceGetAttribute(&cus, hipDeviceAttributeMultiprocessorCount, dev) != hipSuccess) { grid = -1; return; }
        if (hipFuncSetAttribute((const void*)fwd_kernel, hipFuncAttributeMaxDynamicSharedMemorySize, LDS_BYTES) != hipSuccess) { fprintf(stderr, "kernel_launch: hipFuncSetAttribute failed\n"); grid = -1; return; }
        if (hipOccupancyMaxActiveBlocksPerMultiprocessor(&per_cu, (const void*)fwd_kernel, NWAVES * 64, LDS_BYTES) != hipSuccess || per_cu < 1) { fprintf(stderr, "kernel_launch: occupancy query says %d blocks/CU\n", per_cu); grid = -1; (void)hipGetLastError(); return; }
        grid = cus;
    }
    if (grid < 0) return;
    (void)hipMemsetAsync((char*)d_ws + WS_CTL, 0, CTL_ZERO_BYTES, stream);
    Args a{};
    a.x = (const float*)d_in[0]; a.pos = (const int*)d_in[1]; a.w_in = (const float*)d_in[2]; a.w_out = (const float*)d_in[3]; a.mix_w = (const float*)d_in[4];
    a.attn_w = (const float*)d_in[5]; a.hgrn_w = (const float*)d_in[6]; a.lb_raw = (const float*)d_in[7]; a.fin_w = (const float*)d_in[8];
    a.out = (float*)d_out; a.ws = (unsigned char*)d_ws;
    hipLaunchKernelGGL(fwd_kernel, dim3(grid), dim3(NWAVES * 64), LDS_BYTES, stream, a);
}
```
